# Optimizing an MI355X kernel written in HIP

```python
import math
import jax, jax.numpy as jnp
from jax import lax
import numpy as np

D_MODEL = 1024
BATCH = 4
SEQ = 4096
DEPTH = 1
DEC_BATCH = 128
DEC_SEQ = 8
PAST_LEN = 8192
PAGE_SIZE = 128

N_META = 16
D_FF = 2816
DN_DK = 128
DN_DV = 128
DN_HEADS = D_MODEL // DN_DV
DN_CONV = 4
DN_CHUNK = 64
SWA_HD = 128
SWA_HEADS = D_MODEL // SWA_HD
SWA_KV_HEADS = SWA_HEADS // 4
SWA_GROUP = SWA_HEADS // SWA_KV_HEADS
WINDOW = 128
SWA_BLOCK = 128
RMS_EPS = 1e-6
L2_EPS = 1e-6

DN_QK_W = DN_HEADS * DN_DK
DN_V_W = DN_HEADS * DN_DV
DN_CONV_W = 2 * DN_QK_W + DN_V_W
SWA_Q_W = SWA_HEADS * SWA_HD
SWA_KV_W = SWA_KV_HEADS * SWA_HD
IN_SIZES = (DN_CONV_W, DN_V_W, DN_HEADS, DN_HEADS, SWA_Q_W, SWA_KV_W, SWA_KV_W, D_MODEL, D_MODEL)
D_IN = sum(IN_SIZES)

kernel_name = 'hybrid_gdn_swa_macaron_step'


def rms_norm(x, g):
    xf = x.astype(jnp.float32)
    y = xf * lax.rsqrt(jnp.mean(xf * xf, axis=-1, keepdims=True) + RMS_EPS)
    return (y * g.astype(jnp.float32)).astype(x.dtype)


def l2_normalize(x):
    return x * lax.rsqrt(jnp.sum(x * x, axis=-1, keepdims=True) + L2_EPS)


def swiglu(x, w_gate, w_up, w_down):
    return (jax.nn.silu(x @ w_gate) * (x @ w_up)) @ w_down


def half_ffn(h, g_pre, g_post, w_gate, w_up, w_down):
    return h + 0.5 * rms_norm(swiglu(rms_norm(h, g_pre), w_gate, w_up, w_down), g_post)


def causal_conv(xp, w):
    k_w = w.shape[0]
    t = xp.shape[1] - (k_w - 1)
    out = xp[:, 0:t] * w[0]
    for j in range(1, k_w):
        out = out + xp[:, j:j + t] * w[j]
    return out


def alibi_slopes():
    return jnp.exp2(-8.0 * jnp.arange(1, SWA_HEADS + 1, dtype=jnp.float32) / SWA_HEADS)


def gated_delta_chunked(q, k, v, beta, g):
    n, t, h, dk = q.shape
    dv = v.shape[-1]
    c = DN_CHUNK
    nz = t // c

    def blocks(x):
        return jnp.moveaxis(x.reshape((n, nz, c) + x.shape[2:]), 2, 3)

    q, k, v, beta, g = (blocks(x) for x in (q, k, v, beta, g))
    gc = jnp.cumsum(g, axis=-1)
    causal = jnp.tril(jnp.ones((c, c), bool))
    strict = jnp.tril(jnp.ones((c, c), bool), -1)
    diff = gc[..., :, None] - gc[..., None, :]
    decay = jnp.where(causal, jnp.exp(jnp.where(causal, diff, 0.0)), 0.0)
    kk = jnp.einsum('nzhid,nzhjd->nzhij', k, k)
    a_mat = jnp.where(strict, beta[..., :, None] * kk * decay, 0.0) + jnp.eye(c, dtype=q.dtype)
    rhs = jnp.concatenate([v * beta[..., None], k * (beta * jnp.exp(gc))[..., None]], axis=-1)
    sol = lax.linalg.triangular_solve(a_mat, rhs, left_side=True, lower=True, unit_diagonal=True)
    u_base, w = sol[..., :dv], sol[..., dv:]
    qk = jnp.einsum('nzhid,nzhjd->nzhij', q, k) * decay
    q_dec = q * jnp.exp(gc)[..., None]
    k_dec = k * jnp.exp(gc[..., -1:] - gc)[..., None]
    c_dec = jnp.exp(gc[..., -1])

    def step(s, xs):
        u_b, w_c, qk_c, qd_c, kd_c, cd_c = xs
        u = u_b - jnp.einsum('nhcd,nhde->nhce', w_c, s)
        o = jnp.einsum('nhcd,nhde->nhce', qd_c, s) + jnp.einsum('nhij,nhje->nhie', qk_c, u)
        s = s * cd_c[..., None, None] + jnp.einsum('nhcd,nhce->nhde', kd_c, u)
        return s, o

    xs = tuple(jnp.moveaxis(x, 1, 0) for x in (u_base, w, qk, q_dec, k_dec, c_dec))
    s0 = jnp.zeros((n, h, dk, dv), jnp.float32)
    s, o = lax.scan(step, s0, xs)
    o = jnp.transpose(o, (1, 0, 3, 2, 4)).reshape(n, t, h, dv)
    return o, s


def gated_delta_prompt(q, k, v, beta, g):
    pad = (-q.shape[1]) % DN_CHUNK

    def padf(x):
        return jnp.pad(x, ((0, 0), (pad, 0)) + ((0, 0),) * (x.ndim - 2))

    o, s = gated_delta_chunked(padf(q), padf(k), padf(v), padf(beta), padf(g))
    return o[:, pad:], s


def gated_delta_recurrent(q, k, v, beta, g, s0):
    def step(s, xs):
        q_t, k_t, v_t, b_t, g_t = xs
        s = s * jnp.exp(g_t)[..., None, None]
        u = b_t[..., None] * (v_t - jnp.einsum('nhd,nhde->nhe', k_t, s))
        s = s + k_t[..., :, None] * u[..., None, :]
        return s, jnp.einsum('nhd,nhde->nhe', q_t, s)

    xs = tuple(jnp.moveaxis(x, 1, 0) for x in (q, k, v, beta, g))
    s, o = lax.scan(step, s0.astype(jnp.float32), xs)
    return jnp.moveaxis(o, 0, 1), s


def sink_softmax(scores, dist, mask, sinks, slopes):
    m = slopes.reshape(SWA_KV_HEADS, SWA_GROUP, 1, 1)
    logits = jnp.where(mask, scores - m * jnp.minimum(dist, WINDOW).astype(jnp.float32), -jnp.inf)
    sink = jnp.broadcast_to(sinks.astype(jnp.float32).reshape(SWA_KV_HEADS, SWA_GROUP, 1, 1), logits.shape[:-1] + (1,))
    return jax.nn.softmax(jnp.concatenate([logits, sink], axis=-1), axis=-1)[..., :-1]


def swa_banded(q, k, v, sinks, slopes, n_keep):
    n, t = q.shape[:2]
    pad = (-t) % SWA_BLOCK
    nb = (t + pad) // SWA_BLOCK

    def padf(x):
        return jnp.pad(x, ((0, 0), (pad, 0), (0, 0), (0, 0)))

    def band(x):
        xb = x.reshape(n, nb, SWA_BLOCK, SWA_KV_HEADS, SWA_HD)
        prev = jnp.concatenate([jnp.zeros_like(xb[:, :1]), xb[:, :-1]], axis=1)
        return jnp.concatenate([prev, xb], axis=2)

    qb = padf(q).reshape(n, nb, SWA_BLOCK, SWA_KV_HEADS, SWA_GROUP, SWA_HD).astype(jnp.float32)
    kb, vb = band(padf(k)), band(padf(v))
    k_meta, v_meta = k[:, :N_META], v[:, :N_META]
    pos = (jnp.arange(t + pad) - pad).reshape(nb, SWA_BLOCK)
    kpos = jnp.concatenate([pos - SWA_BLOCK, pos], axis=1)
    dist_meta = pos[:, :, None] - jnp.arange(N_META)[None, None, :]
    dist_band = pos[:, :, None] - kpos[:, None, :]
    dist = jnp.concatenate([dist_meta, dist_band], axis=-1)
    mask = jnp.concatenate([dist_meta >= 0,
                            (dist_band >= 0) & (dist_band <= WINDOW) & (kpos[:, None, :] >= N_META)], axis=-1)
    scale = SWA_HD ** -0.5
    scores = jnp.concatenate([
        jnp.einsum('nbqkgd,nskd->nbkgqs', qb, k_meta.astype(jnp.float32)),
        jnp.einsum('nbqkgd,nbskd->nbkgqs', qb, kb.astype(jnp.float32))], axis=-1) * scale
    p = sink_softmax(scores, dist[:, None, None], mask[:, None, None], sinks, slopes).astype(v.dtype)
    o = (jnp.einsum('nbkgqs,nskd->nbqkgd', p[..., :N_META], v_meta)
         + jnp.einsum('nbkgqs,nbskd->nbqkgd', p[..., N_META:], vb))
    o = o.reshape(n, t + pad, SWA_HEADS, SWA_HD)[:, pad:]
    return o, (k_meta, v_meta, k[:, -n_keep:], v[:, -n_keep:])


def swa_step(q, k, v, k_meta, v_meta, k_buf, v_buf, sinks, slopes):
    n, t = q.shape[:2]
    w = k_buf.shape[1]
    k_all = jnp.concatenate([k_buf.astype(k.dtype), k], axis=1)
    v_all = jnp.concatenate([v_buf.astype(v.dtype), v], axis=1)
    qg = q.reshape(n, t, SWA_KV_HEADS, SWA_GROUP, SWA_HD).astype(jnp.float32)
    qpos = PAST_LEN + jnp.arange(t)
    kpos = PAST_LEN - w + jnp.arange(w + t)
    dist_meta = qpos[:, None] - jnp.arange(N_META)[None, :]
    dist_band = qpos[:, None] - kpos[None, :]
    dist = jnp.concatenate([dist_meta, dist_band], axis=-1)
    mask = jnp.concatenate([dist_meta >= 0,
                            (dist_band >= 0) & (dist_band <= WINDOW) & (kpos[None, :] >= N_META)], axis=-1)
    scale = SWA_HD ** -0.5
    scores = jnp.concatenate([
        jnp.einsum('ntkgd,nskd->nkgts', qg, k_meta.astype(jnp.float32)),
        jnp.einsum('ntkgd,nskd->nkgts', qg, k_all.astype(jnp.float32))], axis=-1) * scale
    p = sink_softmax(scores, dist, mask, sinks, slopes).astype(v.dtype)
    o = (jnp.einsum('nkgts,nskd->ntkgd', p[..., :N_META], v_meta.astype(v.dtype))
         + jnp.einsum('nkgts,nskd->ntkgd', p[..., N_META:], v_all))
    return o.reshape(n, t, SWA_HEADS, SWA_HD), (k_all[:, -w:], v_all[:, -w:])


def token_mixer(u, conv_hist, w_in, conv_w, a_log, dt_bias, dn_norm_w, w_out, dn_core, swa_core):
    n, t, _ = u.shape
    f32 = jnp.float32
    split_at = np.cumsum(IN_SIZES)[:-1].tolist()
    qkv_pre, z, b, a, sq, sk, sv, g_dn, g_swa = jnp.split(u @ w_in, split_at, axis=-1)
    xp = jnp.concatenate([conv_hist.astype(u.dtype), qkv_pre], axis=1)
    new_conv = xp[:, -(DN_CONV - 1):]
    qkv = jax.nn.silu(causal_conv(xp, conv_w)).astype(f32)
    dq, dk, dv = jnp.split(qkv, [DN_QK_W, 2 * DN_QK_W], axis=-1)
    dq = l2_normalize(dq.reshape(n, t, DN_HEADS, DN_DK)) * (DN_DK ** -0.5)
    dk = l2_normalize(dk.reshape(n, t, DN_HEADS, DN_DK))
    dv = dv.reshape(n, t, DN_HEADS, DN_DV)
    beta = jax.nn.sigmoid(b.astype(f32))
    g = -jnp.exp(a_log.astype(f32)) * jax.nn.softplus(a.astype(f32) + dt_bias.astype(f32))
    o_dn, s_new = dn_core(dq, dk, dv, beta, g)
    o_dn = rms_norm(o_dn, dn_norm_w) * jax.nn.silu(z.astype(f32).reshape(n, t, DN_HEADS, DN_DV))
    o_dn = o_dn.reshape(n, t, DN_V_W).astype(u.dtype)
    o_sw, swa_states = swa_core(sq.reshape(n, t, SWA_HEADS, SWA_HD),
                                sk.reshape(n, t, SWA_KV_HEADS, SWA_HD),
                                sv.reshape(n, t, SWA_KV_HEADS, SWA_HD))
    o_sw = o_sw.reshape(n, t, SWA_Q_W)
    y = jax.nn.sigmoid(g_dn) * o_dn + jax.nn.sigmoid(g_swa) * o_sw
    return y @ w_out, (new_conv, s_new.astype(u.dtype)) + swa_states


def setup_inputs(seed: int = 0) -> dict:
    key = jax.random.key(seed)
    ks = jax.random.split(key, 40)
    f32 = jnp.float32
    cnt = [0]

    def nk():
        cnt[0] += 1
        return ks[cnt[0] - 1]

    def nrm(shape, scale):
        return jax.random.normal(nk(), shape, f32) * scale

    def gain(width):
        return 1.0 + 0.05 * jax.random.normal(nk(), (DEPTH, width), f32)

    n_keep = min(WINDOW, PAST_LEN)
    inp = {}
    inp['x_prompt'] = nrm((BATCH, SEQ, D_MODEL), 1.0)
    inp['x_sample'] = nrm((DEC_BATCH, DEC_SEQ, D_MODEL), 1.0)
    inp['state_dn_conv'] = nrm((DEPTH, DEC_BATCH, DN_CONV - 1, DN_CONV_W), 1.0)
    inp['state_dn_ssm'] = nrm((DEPTH, DEC_BATCH, DN_HEADS, DN_DK, DN_DV), 0.05)
    inp['cache_swa_meta_k'] = nrm((DEPTH, DEC_BATCH, N_META, SWA_KV_HEADS, SWA_HD), 1.0)
    inp['cache_swa_meta_v'] = nrm((DEPTH, DEC_BATCH, N_META, SWA_KV_HEADS, SWA_HD), 1.0)
    inp['cache_swa_k'] = nrm((DEPTH, DEC_BATCH, n_keep, SWA_KV_HEADS, SWA_HD), 1.0)
    inp['cache_swa_v'] = nrm((DEPTH, DEC_BATCH, n_keep, SWA_KV_HEADS, SWA_HD), 1.0)
    inp['meta_tokens'] = nrm((N_META, D_MODEL), 1.0)
    inp['ffn1_norm_pre'] = gain(D_MODEL)
    inp['ffn1_norm_post'] = gain(D_MODEL)
    inp['ffn1_w_gate'] = nrm((DEPTH, D_MODEL, D_FF), D_MODEL ** -0.5)
    inp['ffn1_w_up'] = nrm((DEPTH, D_MODEL, D_FF), D_MODEL ** -0.5)
    inp['ffn1_w_down'] = nrm((DEPTH, D_FF, D_MODEL), D_FF ** -0.5)
    inp['mix_norm_pre'] = gain(D_MODEL)
    inp['mix_norm_post'] = gain(D_MODEL)
    inp['w_in'] = nrm((DEPTH, D_MODEL, D_IN), D_MODEL ** -0.5)
    inp['dn_conv_w'] = nrm((DEPTH, DN_CONV, DN_CONV_W), DN_CONV ** -0.5)
    inp['dn_a_log'] = jnp.log(jax.random.uniform(nk(), (DEPTH, DN_HEADS), f32, 1.0, 16.0))
    dt = jnp.exp(jax.random.uniform(nk(), (DEPTH, DN_HEADS), f32, math.log(1e-3), math.log(1e-1)))
    inp['dn_dt_bias'] = dt + jnp.log(-jnp.expm1(-dt))
    inp['dn_norm_w'] = gain(DN_DV)
    inp['swa_sinks'] = nrm((DEPTH, SWA_HEADS), 0.5)
    inp['w_out'] = nrm((DEPTH, D_MODEL, D_MODEL), D_MODEL ** -0.5)
    inp['ffn2_norm_pre'] = gain(D_MODEL)
    inp['ffn2_norm_post'] = gain(D_MODEL)
    inp['ffn2_w_gate'] = nrm((DEPTH, D_MODEL, D_FF), D_MODEL ** -0.5)
    inp['ffn2_w_up'] = nrm((DEPTH, D_MODEL, D_FF), D_MODEL ** -0.5)
    inp['ffn2_w_down'] = nrm((DEPTH, D_FF, D_MODEL), D_FF ** -0.5)
    return inp


def reference(x_prompt, x_sample, state_dn_conv, state_dn_ssm, cache_swa_meta_k, cache_swa_meta_v,
              cache_swa_k, cache_swa_v, meta_tokens, ffn1_norm_pre, ffn1_norm_post, ffn1_w_gate,
              ffn1_w_up, ffn1_w_down, mix_norm_pre, mix_norm_post, w_in, dn_conv_w, dn_a_log,
              dn_dt_bias, dn_norm_w, swa_sinks, w_out, ffn2_norm_pre, ffn2_norm_post, ffn2_w_gate,
              ffn2_w_up, ffn2_w_down):
    slopes = alibi_slopes()
    n_keep = min(WINDOW, PAST_LEN)

    def run_layer(h, l, conv_hist, dn_core, swa_core):
        h = half_ffn(h, ffn1_norm_pre[l], ffn1_norm_post[l], ffn1_w_gate[l], ffn1_w_up[l], ffn1_w_down[l])
        y, st = token_mixer(rms_norm(h, mix_norm_pre[l]), conv_hist, w_in[l], dn_conv_w[l], dn_a_log[l],
                            dn_dt_bias[l], dn_norm_w[l], w_out[l], dn_core, swa_core)
        h = h + rms_norm(y, mix_norm_post[l])
        h = half_ffn(h, ffn2_norm_pre[l], ffn2_norm_post[l], ffn2_w_gate[l], ffn2_w_up[l], ffn2_w_down[l])
        return h, st

    n_p = x_prompt.shape[0]
    meta = jnp.broadcast_to(meta_tokens.astype(x_prompt.dtype)[None], (n_p, N_META, D_MODEL))
    hp = jnp.concatenate([meta, x_prompt], axis=1)
    hs = x_sample
    p_st, s_st = [], []
    for l in range(DEPTH):
        conv0 = jnp.zeros((n_p, DN_CONV - 1, DN_CONV_W), hp.dtype)
        hp, st = run_layer(hp, l, conv0, gated_delta_prompt,
                           lambda q, k, v, l=l: swa_banded(q, k, v, swa_sinks[l], slopes, n_keep))
        p_st.append(st)
        hs, st = run_layer(hs, l, state_dn_conv[l],
                           lambda q, k, v, b, g, l=l: gated_delta_recurrent(q, k, v, b, g, state_dn_ssm[l]),
                           lambda q, k, v, l=l: swa_step(q, k, v, cache_swa_meta_k[l], cache_swa_meta_v[l],
                                                         cache_swa_k[l], cache_swa_v[l], swa_sinks[l], slopes))
        s_st.append(st)
    p_conv, p_ssm, p_meta_k, p_meta_v, p_win_k, p_win_v = [jnp.stack(a) for a in zip(*p_st)]
    s_conv, s_ssm, s_win_k, s_win_v = [jnp.stack(a) for a in zip(*s_st)]
    y_prompt = hp[:, N_META:]
    return (y_prompt, hs, p_conv, p_ssm, p_meta_k, p_meta_v, p_win_k, p_win_v, s_conv, s_ssm, s_win_k, s_win_v)
```

```cpp
#include <hip/hip_runtime.h>
#include <cstdio>
#include <cstdint>
#include <cmath>
namespace pg8 {
#define PG8_LAS __attribute__((address_space(3)))
typedef unsigned short bf16_t;
typedef short bf16x8 __attribute__((ext_vector_type(8)));
typedef float f32x4 __attribute__((ext_vector_type(4)));
typedef unsigned u32x4 __attribute__((ext_vector_type(4)));
constexpr int BM = 256, BK = 64, HALF = 128, HTB = HALF * BK * 2  , STAGE_BYTES = 8 * HTB, NXCD = 8, WGM = 8;

__host__ __device__ __forceinline__ int lds_byte(int r, int c) { const int st = (r >> 4) * 2 + (c >> 5), rr = r & 15, cc = c & 31, ob = rr * 64 + cc * 2; return st * 1024 + (ob ^ (((ob >> 9) & 1) << 5)); }
__host__ __device__ __forceinline__ void stage_rc(int b, int& R, int& C) { const int st = b / 1024, sb = b % 1024, swz = sb ^ (((sb >> 9) & 1) << 5); R = (st >> 1) * 16 + swz / 64; C = (st & 1) * 32 + (swz % 64) / 2; }
__host__ __device__ __forceinline__ int perm32(int rho) { const int n = rho >> 4, i = rho & 15; return 8 * (i >> 2) + 4 * n + (i & 3); }

struct Unit { int pm, pn, k0 = 0  , nt = 0  , tail = 0  ; };
struct Gemm { const bf16_t* A; const bf16_t* Bt; int M, N, K; };

struct StaticOrder {
    int nM, nN, nwg, G, c;
    __host__ __device__ void init(int M, int N, int G_, int c_) { nM = M / BM; nN = N / BM; nwg = nM * nN; G = G_; c = c_; }
    __host__ __device__ bool next(int i, Unit& u) const {
        const long L = (long)i * G + c; if (L >= nwg) return false;
        int wgid = (int)L; { const int q = nwg / NXCD, r = nwg % NXCD, xcd = wgid % NXCD, off = wgid / NXCD; wgid = (xcd < r ? xcd * (q + 1) : r * (q + 1) + (xcd - r) * q) + off; }
        const int nig = WGM * nN, gid = wgid / nig, fm = gid * WGM, gsz = (nM - fm) < WGM ? (nM - fm) : WGM;
        u.pm = fm + ((wgid % nig) % gsz); u.pn = (wgid % nig) / gsz; return true;
    }
    __device__ __forceinline__ void a_ready(const Unit&) const {}
    __device__ __forceinline__ void done(const Unit&) const {}
};

__device__ __forceinline__ unsigned cvt_pk_bf16(float lo, float hi) { unsigned r; asm volatile("v_cvt_pk_bf16_f32 %0, %1, %2" : "=v"(r) : "v"(lo), "v"(hi)); return r; }
struct EpiSwiGLU {
    static constexpr bool PERM = true, AFTER_DRAIN = false;
    bf16_t* O; int ldc;
    __device__ __forceinline__ void operator()(const f32x4 (&acc)[2][2][4][2], const Unit& u, int wr, int wc, int fr, int fq) const {
        const int row0 = u.pm * BM + wr * 64 + fr; const int col0 = u.pn * 128 + wc * 32 + 8 * fq;
#pragma unroll
        for (int ai = 0; ai < 2; ++ai)
#pragma unroll
            for (int m = 0; m < 4; ++m) { bf16_t* rowp = O + (size_t)(row0 + ai * HALF + m * 16) * ldc + col0; float h[8];
#pragma unroll
                for (int bj = 0; bj < 2; ++bj) { const f32x4 g = acc[ai][bj][m][0], v = acc[ai][bj][m][1];
#pragma unroll
                    for (int i = 0; i < 4; ++i) { const float e = __builtin_amdgcn_exp2f(g[i] * -1.44269504089f); h[4 * bj + i] = g[i] * __builtin_amdgcn_rcpf(1.0f + e) * v[i]; } }
                u32x4 w; w.x = cvt_pk_bf16(h[0], h[1]); w.y = cvt_pk_bf16(h[2], h[3]); w.z = cvt_pk_bf16(h[4], h[5]); w.w = cvt_pk_bf16(h[6], h[7]);
                *(u32x4*)rowp = w; }
    }
};
struct EpiPlain {
    static constexpr bool PERM = true, AFTER_DRAIN = false;
    bf16_t* O; int ldc;
    __device__ __forceinline__ void operator()(const f32x4 (&acc)[2][2][4][2], const Unit& u, int wr, int wc, int fr, int fq) const {
        const int row0 = u.pm * BM + wr * 64 + fr; const int col0 = u.pn * BM + wc * 32 + 8 * fq;
#pragma unroll
        for (int ai = 0; ai < 2; ++ai)
#pragma unroll
            for (int m = 0; m < 4; ++m) { bf16_t* rowp = O + (size_t)(row0 + ai * HALF + m * 16) * ldc + col0;
#pragma unroll
                for (int bj = 0; bj < 2; ++bj) { const f32x4 v0 = acc[ai][bj][m][0], v1 = acc[ai][bj][m][1];
                    u32x4 w; w.x = cvt_pk_bf16(v0[0], v0[1]); w.y = cvt_pk_bf16(v0[2], v0[3]); w.z = cvt_pk_bf16(v1[0], v1[1]); w.w = cvt_pk_bf16(v1[2], v1[3]);
                    *(u32x4*)(rowp + bj * HALF) = w; } }
    }
};
struct EpiProj {
    static constexpr bool PERM = true, AFTER_DRAIN = false;
    bf16_t *QKV, *SQ, *SKV, *G1, *GS; float* BA;
    __device__ __forceinline__ static float sig(float x) { return __builtin_amdgcn_rcpf(1.0f + __builtin_amdgcn_exp2f(x * -1.44269504089f)); }
    __device__ __forceinline__ void operator()(const f32x4 (&acc)[2][2][4][2], const Unit& u, int wr, int wc, int fr, int fq) const {
        const int pn = u.pn; const int row0 = u.pm * BM + wr * 64 + fr;
        if (pn == 30) {
            if (wc == 0 && fq < 2) {
#pragma unroll
                for (int ai = 0; ai < 2; ++ai)
#pragma unroll
                    for (int m = 0; m < 4; ++m) { float* rowp = BA + (size_t)(row0 + ai * HALF + m * 16) * 16 + 8 * fq;
                        *(f32x4*)(rowp) = acc[ai][0][m][0]; *(f32x4*)(rowp + 4) = acc[ai][0][m][1]; }
            }
            return;
        }
        if (pn >= 12 && pn < 20) {
            const int col0 = (pn - 12) * 128 + wc * 32 + 8 * fq;
#pragma unroll
            for (int ai = 0; ai < 2; ++ai)
#pragma unroll
                for (int m = 0; m < 4; ++m) { bf16_t* rowp = G1 + (size_t)(row0 + ai * HALF + m * 16) * 1024 + col0; float h[8];
#pragma unroll
                    for (int bj = 0; bj < 2; ++bj) { const f32x4 z = acc[ai][bj][m][0], g = acc[ai][bj][m][1];
#pragma unroll
                        for (int i = 0; i < 4; ++i) h[4 * bj + i] = z[i] * __builtin_amdgcn_rcpf((1.0f + __builtin_amdgcn_exp2f(g[i] * -1.44269504089f)) * (1.0f + __builtin_amdgcn_exp2f(z[i] * -1.44269504089f))); }
                    u32x4 w; w.x = cvt_pk_bf16(h[0], h[1]); w.y = cvt_pk_bf16(h[2], h[3]); w.z = cvt_pk_bf16(h[4], h[5]); w.w = cvt_pk_bf16(h[6], h[7]);
                    __builtin_nontemporal_store(w, (u32x4*)rowp); }
            return;
        }
        bf16_t* base; int ldc, colt; bool sg = false;
        if (pn < 12) { base = QKV; ldc = 3072; colt = pn * 256; }
        else if (pn < 24) { base = SQ; ldc = 1024; colt = (pn - 20) * 256; }
        else if (pn < 26) { base = SKV; ldc = 512; colt = (pn - 24) * 256; }
        else { base = GS; ldc = 1024; colt = (pn - 26) * 256; sg = true; }
        const int col0 = colt + wc * 32 + 8 * fq;
#pragma unroll
        for (int ai = 0; ai < 2; ++ai)
#pragma unroll
            for (int m = 0; m < 4; ++m) { bf16_t* rowp = base + (size_t)(row0 + ai * HALF + m * 16) * ldc + col0;
#pragma unroll
                for (int bj = 0; bj < 2; ++bj) { f32x4 v0 = acc[ai][bj][m][0], v1 = acc[ai][bj][m][1];
                    if (sg) { v0 = (f32x4){sig(v0[0]), sig(v0[1]), sig(v0[2]), sig(v0[3])}; v1 = (f32x4){sig(v1[0]), sig(v1[1]), sig(v1[2]), sig(v1[3])}; }
                    u32x4 w; w.x = cvt_pk_bf16(v0[0], v0[1]); w.y = cvt_pk_bf16(v0[2], v0[3]); w.z = cvt_pk_bf16(v1[0], v1[1]); w.w = cvt_pk_bf16(v1[2], v1[3]);
                    if (pn < 12) *(u32x4*)(rowp + bj * HALF) = w; else __builtin_nontemporal_store(w, (u32x4*)(rowp + bj * HALF)); } }
    }
};
struct SplitK {
    int ppu, P, G, c, pn;
    __host__ __device__ static int snap(int x, int ppu) { const int r = x % ppu; return r == 1 ? x - 1 : (r == ppu - 1 ? x + 1 : x); }
    __host__ __device__ int bound(int cc) const { return snap((cc * P) / G, ppu); }
    __host__ __device__ void init(int M, int N, int K, int G_, int c_) { const int ncol = N / BM; ppu = K / 128; P = (M / BM) * ppu; G = G_ / ncol; c = c_ / ncol; pn = c_ % ncol; }
    __host__ __device__ bool next(int i, Unit& u) const {
        int s = bound(c); const int hi = bound(c + 1);
        for (int k = 0;; ++k) { if (s >= hi) return false; const int un = s / ppu, off = s - un * ppu; int len = ppu - off; if (len > hi - s) len = hi - s;
            if (k == i) { u.pm = un; u.pn = pn; u.k0 = 2 * off; u.nt = 2 * len; u.tail = off != 0; return true; }
            s += len; }
    }
    __host__ __device__ bool has_tail(int pm) const {
        const int lo = pm * ppu, hi = lo + ppu; const int c0 = (lo * G) / P;
        for (int cc = c0 - 1; cc <= c0 + 2; ++cc) { if (cc < 1 || cc >= G) continue; const int b = bound(cc); if (b > lo && b < hi) return true; }
        return false;
    }
    __device__ __forceinline__ void a_ready(const Unit&) const {}
    __device__ __forceinline__ void done(const Unit&) const {}
};
struct EpiSplit {
    static constexpr bool PERM = true, AFTER_DRAIN = false;
    bf16_t* OA; bf16_t* OB; int ldc;
    __device__ __forceinline__ void operator()(const f32x4 (&acc)[2][2][4][2], const Unit& u, int wr, int wc, int fr, int fq) const {
        const int row0 = u.pm * BM + wr * 64 + fr; const int col0 = u.pn * BM + wc * 32 + 8 * fq; bf16_t* O = u.tail ? OB : OA;
#pragma unroll
        for (int ai = 0; ai < 2; ++ai)
#pragma unroll
            for (int m = 0; m < 4; ++m) { bf16_t* rowp = O + (size_t)(row0 + ai * HALF + m * 16) * ldc + col0;
#pragma unroll
                for (int bj = 0; bj < 2; ++bj) { const f32x4 v0 = acc[ai][bj][m][0], v1 = acc[ai][bj][m][1];
                    u32x4 w; w.x = cvt_pk_bf16(v0[0], v0[1]); w.y = cvt_pk_bf16(v0[2], v0[3]); w.z = cvt_pk_bf16(v1[0], v1[1]); w.w = cvt_pk_bf16(v1[2], v1[3]);
                    *(u32x4*)(rowp + bj * HALF) = w; } }
    }
};
template <class Epi, class Sched, bool ALIGN_EPI = false, bool SP2 = false>
__device__ __forceinline__ void gemm_phase(PG8_LAS unsigned char* lds, const Gemm g, const Sched& S, const Epi& E) {
    const int tid = threadIdx.x, wid = __builtin_amdgcn_readfirstlane(tid >> 6), lane = tid & 63, wr = wid >> 2, wc = wid & 3, fr = lane & 15, fq = lane >> 4;
    const int K = g.K;
    unsigned voffA[2], voffB[2];
#pragma unroll
    for (int i = 0; i < 2; ++i) { int R, C; stage_rc(tid * 16 + i * 8192, R, C); const int Rb = Epi::PERM ? ((R & ~31) + perm32(R & 31)) : R;
        voffA[i] = (unsigned)(R * K + C) * 2u; voffB[i] = (unsigned)(Rb * K + C) * 2u; }
    const size_t kstep = (size_t)(BK * 2);
    const size_t hstep = (size_t)HALF * K * 2;
    const size_t tstep = 2 * hstep;
    const unsigned ldsw = (unsigned)wid * 1024u;
    const int aoff = lds_byte(wr * 64 + fr, fq * 8), boff = lds_byte(wc * 32 + fr, fq * 8);
#define PG8_SA(b, h) (((b) * 2 + (h)) * HTB)
#define PG8_SB(b, h) ((4 + (b) * 2 + (h)) * HTB)
#define PG8_STAGE(bufoff, gbase, voff) do { _Pragma("unroll") for (int _i = 0; _i < 2; ++_i) \
        __builtin_amdgcn_global_load_lds((const unsigned*)((const char*)(gbase) + (voff)[_i]), (PG8_LAS unsigned*)(lds + (bufoff) + ldsw + _i * 8192), 16, 0, 0); } while (0)
#define PG8_LDA(dst, b, h) do { _Pragma("unroll") for (int m = 0; m < 4; ++m) _Pragma("unroll") for (int k = 0; k < 2; ++k) dst[m][k] = *(const PG8_LAS bf16x8*)(lds + PG8_SA(b, h) + aoff + m * 2048 + k * 1024); } while (0)
#define PG8_LDB(dst, b, h) do { _Pragma("unroll") for (int n = 0; n < 2; ++n) _Pragma("unroll") for (int k = 0; k < 2; ++k) dst[n][k] = *(const PG8_LAS bf16x8*)(lds + PG8_SB(b, h) + boff + n * 2048 + k * 1024); } while (0)
#define PG8_MMA(ai, bj, At, Bt) do { __builtin_amdgcn_s_setprio(1); _Pragma("unroll") for (int m = 0; m < 4; ++m) _Pragma("unroll") for (int n = 0; n < 2; ++n) _Pragma("unroll") for (int k = 0; k < 2; ++k) \
        acc[ai][bj][m][n] = __builtin_amdgcn_mfma_f32_16x16x32_bf16(Bt[n][k], At[m][k], acc[ai][bj][m][n], 0, 0, 0); __builtin_amdgcn_s_setprio(0); } while (0)
#define PG8_WAIT_V(n) asm volatile("s_waitcnt vmcnt(" #n ")" ::: "memory")
#define PG8_WAIT_L(n) asm volatile("s_waitcnt lgkmcnt(" #n ")" ::: "memory")
#define PG8_BAR __builtin_amdgcn_s_barrier()
#define PG8_SCHED __builtin_amdgcn_sched_barrier(0)
    Unit cur, nxt; int ui = 0;
    if (!S.next(0, cur)) return;
    f32x4 acc[2][2][4][2];
#pragma unroll
    for (int a = 0; a < 2; ++a)
#pragma unroll
        for (int b = 0; b < 2; ++b)
#pragma unroll
            for (int m = 0; m < 4; ++m)
#pragma unroll
                for (int n = 0; n < 2; ++n) acc[a][b][m][n] = (f32x4){0.f, 0.f, 0.f, 0.f};
    bf16x8 At[4][2], B0[2][2], B1[2][2];
    const char* cA = (const char*)g.A + (size_t)cur.pm * tstep + (size_t)cur.k0 * kstep; const char* cB = (const char*)g.Bt + (size_t)cur.pn * tstep + (size_t)cur.k0 * kstep;
    S.a_ready(cur);
    if constexpr (SP2) {
        PG8_STAGE(PG8_SB(0, 0), cB, voffB); PG8_STAGE(PG8_SB(0, 1), cB + hstep, voffB); PG8_STAGE(PG8_SA(0, 0), cA, voffA); PG8_STAGE(PG8_SA(0, 1), cA + hstep, voffA);
        if (wr == 1) PG8_BAR;
        PG8_WAIT_V(2); PG8_BAR;
        PG8_STAGE(PG8_SB(1, 0), cB + kstep, voffB); PG8_STAGE(PG8_SA(1, 0), cA + kstep, voffA); PG8_STAGE(PG8_SB(1, 1), cB + hstep + kstep, voffB);
        PG8_WAIT_V(6); PG8_BAR;
    } else {
        PG8_STAGE(PG8_SB(0, 0), cB, voffB); PG8_STAGE(PG8_SA(0, 0), cA, voffA); PG8_STAGE(PG8_SB(0, 1), cB + hstep, voffB); PG8_STAGE(PG8_SA(0, 1), cA + hstep, voffA);
        if (wr == 1) PG8_BAR;
        PG8_WAIT_V(4); PG8_BAR;
        PG8_STAGE(PG8_SB(1, 0), cB + kstep, voffB); PG8_STAGE(PG8_SA(1, 0), cA + kstep, voffA); PG8_STAGE(PG8_SB(1, 1), cB + hstep + kstep, voffB);
        PG8_WAIT_V(6); PG8_BAR;
    }
    for (;;) {
        const bool has_next = S.next(ui + 1, nxt);
        const char* nA = has_next ? (const char*)g.A + (size_t)nxt.pm * tstep + (size_t)nxt.k0 * kstep : cA; const char* nB = has_next ? (const char*)g.Bt + (size_t)nxt.pn * tstep + (size_t)nxt.k0 * kstep : cB;
        const int nt = cur.nt ? cur.nt : K / BK;
        for (int t = 0; t < nt; t += 2) {
            const bool last = (t == nt - 2);
            const char* a1 = cA + (size_t)(t + 1) * kstep;
            const char* a2 = last ? nA : cA + (size_t)(t + 2) * kstep; const char* b2 = last ? nB : cB + (size_t)(t + 2) * kstep;
            const char* a3 = a2 + kstep; const char* b3 = b2 + kstep;
            if (last && has_next) S.a_ready(nxt);
            if constexpr (SP2) {
            PG8_LDB(B0, 0, 0); PG8_LDB(B1, 0, 1); PG8_SCHED; PG8_LDA(At, 0, 0); PG8_STAGE(PG8_SA(1, 1), a1 + hstep, voffA);
            PG8_WAIT_V(8); PG8_WAIT_L(0); PG8_BAR; PG8_MMA(0, 0, At, B0); PG8_MMA(0, 1, At, B1); PG8_BAR; PG8_SCHED;
            PG8_LDA(At, 0, 1); PG8_STAGE(PG8_SB(0, 0), b2, voffB); PG8_STAGE(PG8_SB(0, 1), b2 + hstep, voffB); PG8_STAGE(PG8_SA(0, 0), a2, voffA);
            PG8_WAIT_V(8); PG8_WAIT_L(0); PG8_BAR; PG8_MMA(1, 0, At, B0); PG8_MMA(1, 1, At, B1); PG8_BAR; PG8_SCHED;
            PG8_LDB(B0, 1, 0); PG8_LDB(B1, 1, 1); PG8_SCHED; PG8_LDA(At, 1, 0); PG8_STAGE(PG8_SA(0, 1), a2 + hstep, voffA);
            PG8_WAIT_V(8); PG8_WAIT_L(0); PG8_BAR; PG8_MMA(0, 0, At, B0); PG8_MMA(0, 1, At, B1); PG8_BAR; PG8_SCHED;
            PG8_LDA(At, 1, 1); PG8_STAGE(PG8_SB(1, 0), b3, voffB); PG8_STAGE(PG8_SB(1, 1), b3 + hstep, voffB); PG8_STAGE(PG8_SA(1, 0), a3, voffA);
            PG8_WAIT_V(8); PG8_WAIT_L(0); PG8_BAR; PG8_MMA(1, 0, At, B0); PG8_MMA(1, 1, At, B1); PG8_BAR; PG8_SCHED;
            } else {
            PG8_LDB(B0, 0, 0); PG8_SCHED; PG8_LDA(At, 0, 0); PG8_STAGE(PG8_SA(1, 1), a1 + hstep, voffA);
            PG8_WAIT_L(8); PG8_BAR; PG8_WAIT_L(0); PG8_MMA(0, 0, At, B0); PG8_BAR; PG8_SCHED;
            PG8_LDB(B1, 0, 1); PG8_STAGE(PG8_SB(0, 0), b2, voffB);
            PG8_BAR; PG8_WAIT_L(0); PG8_MMA(0, 1, At, B1); PG8_BAR;
            PG8_LDA(At, 0, 1); PG8_STAGE(PG8_SA(0, 0), a2, voffA);
            PG8_BAR; PG8_WAIT_L(0); PG8_MMA(1, 0, At, B0); PG8_BAR; PG8_SCHED;
            PG8_STAGE(PG8_SB(0, 1), b2 + hstep, voffB);
            PG8_WAIT_V(6); PG8_BAR; PG8_MMA(1, 1, At, B1); PG8_BAR;
            PG8_LDB(B0, 1, 0); PG8_SCHED; PG8_LDA(At, 1, 0); PG8_STAGE(PG8_SA(0, 1), a2 + hstep, voffA);
            PG8_WAIT_L(8); PG8_BAR; PG8_WAIT_L(0); PG8_MMA(0, 0, At, B0); PG8_BAR; PG8_SCHED;
            PG8_LDB(B1, 1, 1); PG8_STAGE(PG8_SB(1, 0), b3, voffB);
            PG8_BAR; PG8_WAIT_L(0); PG8_MMA(0, 1, At, B1); PG8_BAR;
            PG8_LDA(At, 1, 1); PG8_STAGE(PG8_SA(1, 0), a3, voffA);
            PG8_BAR; PG8_WAIT_L(0); PG8_MMA(1, 0, At, B0); PG8_BAR; PG8_SCHED;
            PG8_STAGE(PG8_SB(1, 1), b3 + hstep, voffB);
            PG8_WAIT_V(6); PG8_BAR; PG8_MMA(1, 1, At, B1); PG8_BAR;
            }
        }
        if constexpr (ALIGN_EPI) { if (wr == 0) PG8_BAR; }
        if constexpr (!Epi::AFTER_DRAIN) { E(acc, cur, wr, wc, fr, fq); S.done(cur); }
        if (!has_next) break;
#pragma unroll
        for (int a = 0; a < 2; ++a)
#pragma unroll
            for (int b = 0; b < 2; ++b)
#pragma unroll
                for (int m = 0; m < 4; ++m)
#pragma unroll
                    for (int n = 0; n < 2; ++n) acc[a][b][m][n] = (f32x4){0.f, 0.f, 0.f, 0.f};
        cur = nxt; cA = nA; cB = nB; ++ui;
        if constexpr (ALIGN_EPI) { if (wr == 1) PG8_BAR; }
    }
    PG8_WAIT_V(0);
    if constexpr (!ALIGN_EPI) { if (wr == 0) PG8_BAR; }
    PG8_BAR;
    if constexpr (Epi::AFTER_DRAIN) { E.fused(acc, cur, wr, wc, fr, fq, lds, wid, lane); S.done(cur); }
#undef PG8_SA
#undef PG8_SB
#undef PG8_STAGE
#undef PG8_LDA
#undef PG8_LDB
#undef PG8_MMA
#undef PG8_WAIT_V
#undef PG8_WAIT_L
#undef PG8_BAR
#undef PG8_SCHED
}
}
constexpr int NWAVES = 8;
constexpr int D = 1024, FF = 2816, NB = 4, SEQ = 4096, NMETA = 16, TP = SEQ + NMETA  , PROWS = NB * TP  ;
constexpr int SB = 128, ST = 8, SROWS = SB * ST  , R = PROWS + SROWS  , MP = 17664  ;
constexpr int NH = 8, HD = 128, KVH = 2, NCH = 64  , CH1 = 32  ;
constexpr int NPROJ = 7936, DIN = 7696;
constexpr float RMS_EPS = 1e-6f, L2_EPS = 1e-6f;
constexpr int NPHASE = 16;
#ifndef PROBE_REPS
#define PROBE_REPS {1,1,1,1,1,1,1,1,1,1,1,1,1,1,1,1}
#endif
#ifndef MK_N_LAUNCHES
#define MK_N_LAUNCHES 1
#endif

constexpr size_t O_YP = 0, O_YS = 16777216, O_PCONV = 17825792, O_PSSM = 17862656, O_PMK = 18386944, O_PMV = 18403328, O_PWK = 18419712, O_PWV = 18550784,
                 O_SCONV = 18681856, O_SSSM = 19861504, O_SWK = 36638720, O_SWV = 40833024, O_END = 45027328;
constexpr size_t SR_XN = 0, SR_W3 = SR_XN + (size_t)MP * D * 2, SR_WGU1 = SR_W3 + (size_t)NPROJ * D * 2, SR_WD1 = SR_WGU1 + (size_t)2 * FF * D * 2, SR_END1 = SR_WD1 + (size_t)D * FF * 2;
constexpr size_t DNI_REC = 73728, SR_DNI = 0, SR_END2 = SR_DNI + (size_t)32 * CH1 * DNI_REC;
static_assert(SR_END1 <= (O_END - O_SCONV) * 4 && SR_END2 <= (O_END - O_SCONV) * 4, "SREG map");
constexpr size_t MiB = 1u << 20;
constexpr size_t WS_CTL = 0, CTL_ZERO_BYTES = 64 * 1024;
constexpr size_t WS_QKV = 1 * MiB, WS_Z = WS_QKV + (size_t)MP * 3072 * 2, WS_SQ = WS_Z + (size_t)MP * D * 2, WS_SKV = WS_SQ + (size_t)MP * D * 2, WS_GD = WS_SKV + (size_t)MP * 512 * 2,
                 WS_GS = WS_GD + (size_t)MP * D * 2, WS_BA = WS_GS + (size_t)MP * D * 2, WS_WO = WS_BA + (size_t)MP * 16 * 4, WS_METAH = WS_WO + (size_t)D * D * 2,
                 WS_SSAVE = WS_METAH + (size_t)NB * NMETA * D * 4, WS_CDEC = WS_SSAVE + (size_t)32 * 128 * 128 * 4, WS_CSAVE = WS_CDEC + 32 * NCH * 4 + 128  ,
                 WS_OS = WS_CSAVE + (size_t)NB * 3 * 3072 * 2  , WS_SMETA = WS_OS + (size_t)SROWS * D * 2  , WS_END = WS_SMETA + (size_t)NH * 128 * 128 * 4;
constexpr size_t WS_HID = 1 * MiB, WS_F = WS_SQ, WS_FB = WS_GS, WS_XN2 = WS_SKV, WS_WGU2 = WS_Z, WS_WD2 = WS_WGU2 + (size_t)2 * FF * D * 2, WS_OVL_END = WS_WD2 + (size_t)D * FF * 2;
static_assert(WS_HID + (size_t)MP * FF * 2 <= WS_Z && WS_OVL_END <= WS_SQ && WS_XN2 + (size_t)MP * D * 2 <= WS_GS, "FFN overlays: HID clear of the ffn2 weight copies, those inside the z slot, XN2 clear of FB");
static_assert(WS_END <= 285942368, "d_ws budget: sum of the inputs");
static_assert(WS_CDEC % 256 == 0 && WS_CSAVE % 16 == 0 && WS_BA % 256 == 0, "alignment");
constexpr int CW_Q = 64  , CW_BAR = 4096, CW_SDN = 8192  ;

constexpr int RING_BYTES = 152576  , LDSCTL_OFF = RING_BYTES, MISC_OFF = LDSCTL_OFF + 320, LDS_BYTES = 155648;

#define GAS __attribute__((address_space(1)))
#define LAS __attribute__((address_space(3)))
typedef unsigned short bf16;
typedef unsigned v4u __attribute__((ext_vector_type(4)));
typedef unsigned v2u __attribute__((ext_vector_type(2)));
typedef float f32x4 __attribute__((ext_vector_type(4)));
typedef short bf16x8 __attribute__((ext_vector_type(8)));
typedef short bf16x4 __attribute__((ext_vector_type(4)));
typedef GAS unsigned gu32;
#define RLX_AGENT __ATOMIC_RELAXED, __HIP_MEMORY_SCOPE_AGENT
#define LDS_WAIT() asm volatile("s_waitcnt lgkmcnt(0)" ::: "memory")
#define VM_WAIT() asm volatile("s_waitcnt vmcnt(0)" ::: "memory")
#define LDS_BARRIER() do { asm volatile("s_waitcnt lgkmcnt(0)" ::: "memory"); __builtin_amdgcn_s_barrier(); asm volatile("" ::: "memory"); } while (0)
#define MFMA16(a, b, c) __builtin_amdgcn_mfma_f32_16x16x32_bf16((a), (b), (c), 0, 0, 0)
typedef float f32x2_ __attribute__((ext_vector_type(2)));
typedef __bf16 bf16x2_ __attribute__((ext_vector_type(2)));
__device__ __forceinline__ unsigned pk2(float lo, float hi) { const f32x2_ v = {lo, hi}; return __builtin_bit_cast(unsigned, __builtin_convertvector(v, bf16x2_)); }
__device__ __forceinline__ unsigned f2bf(float f) { return (unsigned)__builtin_bit_cast(unsigned short, (__bf16)f); }
#define LDNT(p) __builtin_nontemporal_load(p)
template <class T> __device__ __forceinline__ void stnt_(T v, T* p) { __builtin_nontemporal_store(v, p); }
#define STNT(...) stnt_(__VA_ARGS__)
__device__ __forceinline__ float bflo(unsigned w) { return __builtin_bit_cast(float, w << 16); }
__device__ __forceinline__ float bfhi(unsigned w) { return __builtin_bit_cast(float, w & 0xffff0000u); }
__device__ __forceinline__ float bf1(bf16 h) { return __builtin_bit_cast(float, (unsigned)h << 16); }
__device__ __forceinline__ float sigmoidf_(float x) { return __builtin_amdgcn_rcpf(1.0f + __builtin_amdgcn_exp2f(x * -1.44269504089f)); }
__device__ __forceinline__ float siluf_(float x) { return x * sigmoidf_(x); }
template <int CTRL> __device__ __forceinline__ float dpp_(float v) { return __builtin_bit_cast(float, __builtin_amdgcn_update_dpp(0, __builtin_bit_cast(int, v), CTRL, 0xf, 0xf, false)); }
__device__ __forceinline__ float xl1(float v) { return dpp_<0xB1>(v); }
__device__ __forceinline__ float xl2(float v) { return dpp_<0x4E>(v); }
__device__ __forceinline__ float xr4(float v) { return dpp_<0x124>(v); }
__device__ __forceinline__ float xr8(float v) { return dpp_<0x128>(v); }
__device__ __forceinline__ float xh4(float v) { return dpp_<0x141>(v); }
__device__ __forceinline__ void plswap16(float& a, float& b) { asm("s_nop 1\n\tv_permlane16_swap_b32 %0, %1" : "+v"(a), "+v"(b)); }
__device__ __forceinline__ void plswap32(float& a, float& b) { asm("s_nop 1\n\tv_permlane32_swap_b32 %0, %1" : "+v"(a), "+v"(b)); }
__device__ __forceinline__ float sum_x16(float v) { float a = v, b = v; plswap16(a, b); return a + b; }
__device__ __forceinline__ float sum_x32(float v) { float a = v, b = v; plswap32(a, b); return a + b; }
__device__ __forceinline__ float max_x16(float v) { float a = v, b = v; plswap16(a, b); return fmaxf(a, b); }
__device__ __forceinline__ float max_x32(float v) { float a = v, b = v; plswap32(a, b); return fmaxf(a, b); }
__device__ __forceinline__ float row_sum16(float v) { v += xl1(v); v += xl2(v); v += xr4(v); v += xr8(v); return v; }
__device__ __forceinline__ float wave_sum(float v) { return sum_x32(sum_x16(row_sum16(v))); }
#define XB_TMO      128
#define XB_XCNT(j)  (256  + 64 * (j))
#define XB_XSUB(j)  (1280 + 64 * (j))
#define XB_XGEN(j)  (2304 + 64 * (j))
#define XB_TOP      3328
#define XB_TOPGEN   3392
#define XCD_BAR_WORDS 3456
#define XB_SPIN_CAP (1u << 18)

__device__ __forceinline__ unsigned xb_ld(unsigned* p)              { return __hip_atomic_load(p, __ATOMIC_RELAXED, __HIP_MEMORY_SCOPE_AGENT); }
__device__ __forceinline__ unsigned xb_add(unsigned* p, unsigned v) { return __hip_atomic_fetch_add(p, v, __ATOMIC_RELAXED, __HIP_MEMORY_SCOPE_AGENT); }
__device__ __forceinline__ unsigned xb_xcc_id() { return (unsigned)__builtin_amdgcn_s_getreg((3 << 11) | 20) & 0xFu; }
#define XB_SPIN(cond, bar) do { unsigned _sp = 0; while (cond) { __builtin_amdgcn_s_sleep(1); \
    if ((++_sp & 255u) == 0u) { if (xb_ld(&(bar)[XB_TMO])) break; if (_sp > XB_SPIN_CAP) { atomicAdd(&(bar)[XB_TMO], 1u); break; } } } } while (0)

struct XcdBarrier {
    unsigned* bar; unsigned x;
    volatile LAS unsigned* st;
};

__device__ __forceinline__ XcdBarrier xcd_barrier_post(unsigned* bar, volatile LAS unsigned* st) {
    XcdBarrier b; b.bar = bar; b.x = xb_xcc_id(); b.st = st;
    if (threadIdx.x == 0) (void)xb_add(&bar[XB_XCNT(b.x)], 1u);
    return b;
}
__device__ __forceinline__ void xcd_barrier_complete(unsigned* bar, unsigned x, unsigned& nloc, unsigned& nx) {
    const unsigned G = gridDim.x * gridDim.y * gridDim.z;
    unsigned sum, cnt, mine, sp = 0u;
    for (;;) {
        sum = 0u; cnt = 0u; mine = 0u;
#pragma unroll
        for (unsigned j = 0; j < 16; ++j) { const unsigned c = xb_ld(&bar[XB_XCNT(j)]); sum += c; cnt += (c > 0u) ? 1u : 0u; mine = (j == x) ? c : mine; }
        if (sum == G) break;
        __builtin_amdgcn_s_sleep(1);
        if ((++sp & 255u) == 0u) { if (xb_ld(&bar[XB_TMO])) break; if (sp > XB_SPIN_CAP) { atomicAdd(&bar[XB_TMO], 1u); break; } }
    }
    nloc = mine > 0u ? mine : 1u; nx = cnt > 0u ? cnt : 1u;
}

__device__ __forceinline__ void xcd_barrier(const XcdBarrier& b) {
    asm volatile("s_waitcnt vmcnt(0)" ::: "memory");
    __syncthreads();
    if (threadIdx.x == 0) {
        unsigned* bar = b.bar;
        __builtin_amdgcn_s_waitcnt(0);
        unsigned nloc = b.st[0], nx = b.st[1];
        if (nloc == 0u) { xcd_barrier_complete(bar, b.x, nloc, nx); b.st[0] = nloc; b.st[1] = nx; }
        const unsigned old = xb_add(&bar[XB_XSUB(b.x)], 1u);
        const unsigned gen = old / nloc;
        if (old + 1u == (gen + 1u) * nloc) {
            __builtin_amdgcn_fence(__ATOMIC_RELEASE, "agent");
            asm volatile("s_waitcnt vmcnt(0)" ::: "memory");
            const unsigned og = xb_add(&bar[XB_TOP], 1u);
            const unsigned tg = og / nx;
            if (og + 1u == (tg + 1u) * nx) xb_add(&bar[XB_TOPGEN], 1u);
            else XB_SPIN(xb_ld(&bar[XB_TOPGEN]) == tg, bar);
            __builtin_amdgcn_fence(__ATOMIC_ACQUIRE, "agent");
            xb_add(&bar[XB_XGEN(b.x)], 1u);
            asm volatile("s_waitcnt vmcnt(0)" ::: "memory");
        } else {
            XB_SPIN(xb_ld(&bar[XB_XGEN(b.x)]) == gen, bar);
            __builtin_amdgcn_fence(__ATOMIC_ACQUIRE, "agent");
            asm volatile("s_waitcnt vmcnt(0)" ::: "memory");
        }
    }
    __syncthreads();
}
struct Args { const float* in[28]; float* out; unsigned char* ws; int ph_lo, ph_hi, li, pad; };
struct Ctx { LAS unsigned char* lds; volatile LAS unsigned* MISC; gu32* ctl; int wave, vcu, G; };

__device__ __forceinline__ const float* h0_row(const Args& a, int r) {
    if (r >= PROWS) return a.in[1] + (size_t)(r - PROWS) * D;
    const int b = r / TP, t = r - b * TP;
    return t < NMETA ? a.in[8] + (size_t)t * D : a.in[0] + ((size_t)b * SEQ + (t - NMETA)) * D;
}
__device__ __forceinline__ float* h_row(const Args& a, int r) {
    if (r >= PROWS) return a.out + O_YS + (size_t)(r - PROWS) * D;
    const int b = r / TP, t = r - b * TP;
    return t < NMETA ? (float*)(a.ws + WS_METAH) + (size_t)(b * NMETA + t) * D : a.out + O_YP + ((size_t)b * SEQ + (t - NMETA)) * D;
}

__device__ __forceinline__ int pair_row(int h, int which) { return 128 * ((h >> 2) & 1) + 32 * (h >> 5) + 8 * ((h >> 3) & 3) + 4 * which + (h & 3); }
__device__ __forceinline__ int rowmap(int mode, int c) {
    if (mode == 1 || mode == 2) return 256 * (c >> 7) + pair_row(c & 127, mode - 1);
    if (mode == 3) {
        if (c < 3072) return c;
        if (c < 4096) { const int zc = c - 3072; return 3072 + 256 * (zc >> 7) + pair_row(zc & 127, 0); }
        if (c < 4112) return 7680 + (c - 4096);
        if (c < 5136) return 5120 + (c - 4112);
        if (c < 5648) return 6144 + (c - 5136);
        if (c < 6672) { const int gc = c - 5648; return 3072 + 256 * (gc >> 7) + pair_row(gc & 127, 1); }
        return 6656 + (c - 6672);
    }
    return c;
}
struct TrJob { const float* W; bf16* WT; int K, N, mode; };
struct TrSel { const float* W; bf16* WT; int K, N, mode, item; };
__device__ __forceinline__ void transpose_load(const TrSel& t, int lane, f32x4 (&v)[8]) {
    const int nblk = (t.N + 31) / 32, kb = t.item / nblk, nb = t.item - kb * nblk, k0 = 64 * kb, n0 = 32 * nb;
    const int cn = n0 + 4 * (lane & 7); const bool cok = cn < t.N;
    const float* src = t.W + (size_t)(k0 + (lane >> 3)) * t.N + (cok ? cn : 0);
#pragma unroll
    for (int i = 0; i < 8; ++i) v[i] = LDNT((const f32x4*)(src + (size_t)(8 * i) * t.N));
}
__device__ __forceinline__ void transpose_store(const TrSel& t, LAS float* scr, int lane, const f32x4 (&v)[8]) {
    const int nblk = (t.N + 31) / 32, kb = t.item / nblk, nb = t.item - kb * nblk, k0 = 64 * kb, n0 = 32 * nb;
    const int cn = n0 + 4 * (lane & 7); const bool cok = cn < t.N;
#pragma unroll
    for (int i = 0; i < 8; ++i) { LAS float* d = scr + (8 * i + (lane >> 3)) * 33 + 4 * (lane & 7); const f32x4 x = cok ? v[i] : (f32x4){0.f, 0.f, 0.f, 0.f};
        d[0] = x.x; d[1] = x.y; d[2] = x.z; d[3] = x.w; }
    LDS_WAIT(); asm volatile("" ::: "memory");
    const int c = lane & 7;
#pragma unroll
    for (int j = 0; j < 4; ++j) { const int n = (lane >> 3) + 8 * j; const LAS float* s = scr + (8 * c) * 33 + n;
        v4u o; o.x = pk2(s[0 * 33], s[1 * 33]); o.y = pk2(s[2 * 33], s[3 * 33]); o.z = pk2(s[4 * 33], s[5 * 33]); o.w = pk2(s[6 * 33], s[7 * 33]);
        if (n0 + n < t.N) *(v4u*)(t.WT + (size_t)rowmap(t.mode, n0 + n) * t.K + k0 + 8 * c) = o; }
    LDS_WAIT(); asm volatile("" ::: "memory");
}
template <int NJ> __device__ __forceinline__ int transpose_total(const TrJob (&jobs)[NJ]) { int total = 0;
#pragma unroll
    for (int j = 0; j < NJ; ++j) total += (jobs[j].K / 64) * ((jobs[j].N + 31) / 32);
    return total; }
template <int NJ> __device__ __forceinline__ void transpose_batch(const Ctx& C, const TrJob (&jobs)[NJ], int batch) {
    constexpr int TB = 5;
    LAS float* scr = (LAS float*)(C.lds + C.wave * 16384);
    const int lane = (int)threadIdx.x & 63, total = transpose_total<NJ>(jobs), it0 = batch * (TB * NWAVES) + C.wave;
    TrSel sel[TB]; f32x4 v[TB][8];
#pragma unroll
    for (int b = 0; b < TB; ++b) { int r = it0 + b * NWAVES < total ? it0 + b * NWAVES : 0;
        sel[b] = TrSel{jobs[0].W, jobs[0].WT, jobs[0].K, jobs[0].N, jobs[0].mode, 0};
#pragma unroll
        for (int j = 0; j < NJ; ++j) { const int nj = (jobs[j].K / 64) * ((jobs[j].N + 31) / 32);
            if (r >= 0 && r < nj) sel[b] = TrSel{jobs[j].W, jobs[j].WT, jobs[j].K, jobs[j].N, jobs[j].mode, r};
            r -= nj; }
        transpose_load(sel[b], lane, v[b]); }
#pragma unroll
    for (int b = 0; b < TB; ++b) { if (it0 + b * NWAVES >= total) break; transpose_store(sel[b], scr, lane, v[b]); }
}
template <int NJ> __device__ __forceinline__ void transpose_jobs(const Ctx& C, const TrJob (&jobs)[NJ]) {
    constexpr int TB = 5;
    LAS float* scr = (LAS float*)(C.lds + C.wave * 16384);
    const int gw = C.vcu * NWAVES + C.wave, NGW = C.G * NWAVES, lane = (int)threadIdx.x & 63;
    int total = 0;
#pragma unroll
    for (int j = 0; j < NJ; ++j) total += (jobs[j].K / 64) * ((jobs[j].N + 31) / 32);
    for (int it0 = gw; it0 < total; it0 += TB * NGW) {
        TrSel sel[TB]; f32x4 v[TB][8];
#pragma unroll
        for (int b = 0; b < TB; ++b) { int r = it0 + b * NGW < total ? it0 + b * NGW : it0;
            sel[b] = TrSel{jobs[0].W, jobs[0].WT, jobs[0].K, jobs[0].N, jobs[0].mode, 0};
#pragma unroll
            for (int j = 0; j < NJ; ++j) { const int nj = (jobs[j].K / 64) * ((jobs[j].N + 31) / 32);
                if (r >= 0 && r < nj) sel[b] = TrSel{jobs[j].W, jobs[j].WT, jobs[j].K, jobs[j].N, jobs[j].mode, r};
                r -= nj; }
            transpose_load(sel[b], lane, v[b]); }
#pragma unroll
        for (int b = 0; b < TB; ++b) { if (it0 + b * NGW >= total) break; transpose_store(sel[b], scr, lane, v[b]); }
    }
}

__device__ __forceinline__ void store_bf16_row(bf16* orow, int lane, const f32x4 (&v)[4]) {
    unsigned long long* o8 = (unsigned long long*)orow + lane;
#pragma unroll
    for (int j = 0; j < 4; ++j) o8[64 * j] = (unsigned long long)pk2(v[j].x, v[j].y) | ((unsigned long long)pk2(v[j].z, v[j].w) << 32);
}
__device__ __forceinline__ void load_bf16_row(const bf16* irow, int lane, f32x4 (&v)[4]) {
    const v2u* i8 = (const v2u*)irow + lane;
#pragma unroll
    for (int j = 0; j < 4; ++j) { const v2u w = i8[64 * j]; v[j] = (f32x4){bflo(w.x), bfhi(w.x), bflo(w.y), bfhi(w.y)}; }
}
__device__ __forceinline__ float sumsq4(const f32x4 (&v)[4]) {
    float s = 0.f;
#pragma unroll
    for (int j = 0; j < 4; ++j) s += (v[j].x * v[j].x + v[j].y * v[j].y) + (v[j].z * v[j].z + v[j].w * v[j].w);
    return wave_sum(s);
}
__device__ __forceinline__ void rows_norm0(const Ctx& C, const Args& a, const float* g, bf16* XN) {
    const int gw = C.vcu * NWAVES + C.wave, NGW = C.G * NWAVES;
    f32x4 gv[4];
#pragma unroll
    for (int j = 0; j < 4; ++j) gv[j] = ((const f32x4*)g)[((int)threadIdx.x & 63) + 64 * j];
    for (int r0 = gw; r0 < R; r0 += 3 * NGW) {
        f32x4 v[3][4];
#pragma unroll
        for (int b = 0; b < 3; ++b) { const int r = r0 + b * NGW < R ? r0 + b * NGW : r0; const f32x4* xr = (const f32x4*)h0_row(a, r) + ((int)threadIdx.x & 63);
#pragma unroll
            for (int j = 0; j < 4; ++j) v[b][j] = LDNT(xr + 64 * j); }
#pragma unroll
        for (int b = 0; b < 3; ++b) { const int r = r0 + b * NGW; if (r >= R) break;
            const float rs = rsqrtf(sumsq4(v[b]) * (1.f / D) + RMS_EPS);
#pragma unroll
            for (int j = 0; j < 4; ++j) v[b][j] = v[b][j] * rs * gv[j];
            store_bf16_row(XN + (size_t)r * D, ((int)threadIdx.x & 63), v[b]); }
    }
}
__device__ __forceinline__ void tail_table(const Ctx& C, const pg8::SplitK& SK) {
    LAS unsigned char* tab = C.lds;
    for (int u = (int)threadIdx.x; u < (MP / 256) * 4; u += NWAVES * 64) tab[u] = SK.has_tail(u >> 2) ? 1 : 0;
    __syncthreads();
}
constexpr int RB = 3;
struct FRaw { v2u a[4], b[4]; unsigned fl; };
__device__ __forceinline__ void f_issue(const bf16* FA, const bf16* FBp, const LAS unsigned char* tab, int r, int lane, FRaw& x) {
    const v2u* pa = (const v2u*)(FA + (size_t)r * D) + lane;
#pragma unroll
    for (int j = 0; j < 4; ++j) { x.a[j] = LDNT(pa + 64 * j); x.b[j] = (v2u){0u, 0u}; }
    x.fl = *(const LAS unsigned*)(tab + (r >> 8) * 4);
    if (x.fl) { const v2u* pb = (const v2u*)(FBp + (size_t)r * D) + lane;
#pragma unroll
        for (int j = 0; j < 4; ++j) x.b[j] = LDNT(pb + 64 * j); }
}
__device__ __forceinline__ void f_finish(const FRaw& x, f32x4 (&f)[4]) {
#pragma unroll
    for (int j = 0; j < 4; ++j) { f[j] = (f32x4){bflo(x.a[j].x), bfhi(x.a[j].x), bflo(x.a[j].y), bfhi(x.a[j].y)};
        if ((x.fl >> (8 * j)) & 1u) f[j] += (f32x4){bflo(x.b[j].x), bfhi(x.b[j].x), bflo(x.b[j].y), bfhi(x.b[j].y)}; }
}
template <bool FIRST> __device__ __forceinline__ void rows_mid(const Ctx& C, const Args& a, const bf16* Fb, const bf16* FBp, const pg8::SplitK& SK, const float* gpost, float scale, const float* gnext, bf16* XN) {
    const int gw = C.vcu * NWAVES + C.wave, NGW = C.G * NWAVES, lane = (int)threadIdx.x & 63;
    tail_table(C, SK);
    f32x4 gp[4], gn[4];
#pragma unroll
    for (int j = 0; j < 4; ++j) { gp[j] = ((const f32x4*)gpost)[lane + 64 * j]; gn[j] = ((const f32x4*)gnext)[lane + 64 * j]; }
    for (int r0 = gw; r0 < R; r0 += RB * NGW) {
        FRaw fr_[RB]; f32x4 h32[RB][4]; v2u hb[RB][4];
#pragma unroll
        for (int b = 0; b < RB; ++b) { const int r = r0 + b * NGW < R ? r0 + b * NGW : r0;
            f_issue(Fb, FBp, C.lds, r, lane, fr_[b]);
            if (FIRST) { const f32x4* hr = (const f32x4*)h0_row(a, r) + lane;
#pragma unroll
                for (int j = 0; j < 4; ++j) h32[b][j] = LDNT(hr + 64 * j); }
            else { const v2u* hp = (const v2u*)h_row(a, r) + lane;
#pragma unroll
                for (int j = 0; j < 4; ++j) hb[b][j] = LDNT(hp + 64 * j); } }
#pragma unroll
        for (int b = 0; b < RB; ++b) { const int r = r0 + b * NGW; if (r >= R) break;
            f32x4 f[4], h[4]; f_finish(fr_[b], f);
#pragma unroll
            for (int j = 0; j < 4; ++j) h[j] = FIRST ? h32[b][j] : (f32x4){bflo(hb[b][j].x), bfhi(hb[b][j].x), bflo(hb[b][j].y), bfhi(hb[b][j].y)};
            const float rs = rsqrtf(sumsq4(f) * (1.f / D) + RMS_EPS) * scale;
#pragma unroll
            for (int j = 0; j < 4; ++j) h[j] = h[j] + f[j] * rs * gp[j];
            store_bf16_row((bf16*)h_row(a, r), lane, h);
            const float rs2 = rsqrtf(sumsq4(h) * (1.f / D) + RMS_EPS);
#pragma unroll
            for (int j = 0; j < 4; ++j) h[j] = h[j] * rs2 * gn[j];
            store_bf16_row(XN + (size_t)r * D, lane, h); }
    }
}
__device__ __forceinline__ void rows_final(const Ctx& C, const Args& a, const bf16* Fb, const bf16* FBp, const pg8::SplitK& SK, const float* gpost) {
    const int gw = C.vcu * NWAVES + C.wave, NGW = C.G * NWAVES, lane = (int)threadIdx.x & 63;
    tail_table(C, SK);
    f32x4 gp[4];
#pragma unroll
    for (int j = 0; j < 4; ++j) gp[j] = ((const f32x4*)gpost)[lane + 64 * j];
    for (int r0 = gw; r0 < R; r0 += RB * NGW) {
        FRaw fr_[RB]; v2u hb[RB][4];
#pragma unroll
        for (int b = 0; b < RB; ++b) { const int r = r0 + b * NGW < R ? r0 + b * NGW : r0;
            f_issue(Fb, FBp, C.lds, r, lane, fr_[b]);
            const v2u* hp = (const v2u*)h_row(a, r) + lane;
#pragma unroll
            for (int j = 0; j < 4; ++j) hb[b][j] = LDNT(hp + 64 * j); }
        asm volatile("s_waitcnt vmcnt(0)" ::: "memory");
#pragma unroll
        for (int b = 0; b < RB; ++b) { const int r = r0 + b * NGW; if (r >= R) break;
            if (r < PROWS && (r % TP) < NMETA) continue;
            f32x4 f[4]; f_finish(fr_[b], f);
            f32x4* hr = (f32x4*)h_row(a, r) + lane;
            const float rs = rsqrtf(sumsq4(f) * (1.f / D) + RMS_EPS) * 0.5f;
#pragma unroll
            for (int j = 0; j < 4; ++j) STNT((f32x4){bflo(hb[b][j].x), bfhi(hb[b][j].x), bflo(hb[b][j].y), bfhi(hb[b][j].y)} + f[j] * rs * gp[j], hr + 64 * j); }
    }
}

__device__ __forceinline__ int queue_next(const Ctx& C, int qid) {
    __syncthreads();
    if (((int)threadIdx.x) == 0) C.MISC[16] = __hip_atomic_fetch_add((unsigned*)(C.ctl + CW_Q + 64 * qid), 1u, RLX_AGENT);
    __syncthreads();
    return (int)C.MISC[16];
}
constexpr int L_KH = 0, L_QH = 17408, L_KTT = 34816, L_VTT = 53248, L_KDS = 71680, L_AM = 90112, L_TB = 107520, L_SC = 116736, L_CW = 117504, L_QST = 123648  , L_WST = 0  , L_UST = 17408  , AML = 68  ;
constexpr int R_W = 0, R_UBT = 16384, R_QD = 32768, R_KDT = 49152, R_QK = 65536;

template <int K> __device__ __forceinline__ float bc(float v) { return __builtin_bit_cast(float, __builtin_amdgcn_update_dpp(0, __builtin_bit_cast(int, v), 0x150 + K, 0xf, 0xf, false)); }
#define BC_STEP(K, AK, B0, B1, B2, B3, C0, C1, C2, C3) { const float ak_ = (AK); const float t0_ = bc<K>(B0), t1_ = bc<K>(B1), t2_ = bc<K>(B2), t3_ = bc<K>(B3); C0 += t0_ * ak_; C1 += t1_ * ak_; C2 += t2_ * ak_; C3 += t3_ * ak_; }
#define BC_STEP4(Q, AV, SGN, B0, B1, B2, B3, C0, C1, C2, C3) BC_STEP(4 * Q, SGN AV.x, B0, B1, B2, B3, C0, C1, C2, C3) BC_STEP(4 * Q + 1, SGN AV.y, B0, B1, B2, B3, C0, C1, C2, C3) \
    BC_STEP(4 * Q + 2, SGN AV.z, B0, B1, B2, B3, C0, C1, C2, C3) BC_STEP(4 * Q + 3, SGN AV.w, B0, B1, B2, B3, C0, C1, C2, C3)
__device__ __forceinline__ void blk_mm(const LAS float* A, int lda, const LAS float* B, int ldb, f32x4& acc, int a, int cg) {
#pragma unroll
    for (int ks = 0; ks < 4; ++ks) acc = __builtin_amdgcn_mfma_f32_16x16x4f32(B[(4 * ks + cg) * ldb + a], A[a * lda + 4 * ks + cg], acc, 0, 0, 0);
}

struct PreLd { v4u stg[7]; float ba0, ba1, cw[3]; };
__device__ __forceinline__ void pre_item_of(int it, int jbase, int& n, int& h, int& j, int& nh, int& jl) { jl = it / 32; nh = it - jl * 32; n = nh >> 3; h = nh & 7; j = jbase + jl; }
__device__ __forceinline__ void pre_issue(const Args& a, int n, int h, int j, PreLd& L) {
    int tid = ((int)threadIdx.x); asm volatile("" : "+v"(tid));
    const bf16* QKV = (const bf16*)(a.ws + WS_QKV); const float* BA = (const float*)(a.ws + WS_BA); const bf16* CSAVE = (const bf16*)(a.ws + WS_CSAVE);
    const int i = tid >> 3, sub = tid & 7, t = 64 * j + 16 + i;
#pragma unroll
    for (int k = 0; k < 7; ++k) { const int p = tid + 512 * k, pc = p < 3216 ? p : 3215, r = pc / 48, sl = pc - 48 * r, arr = sl >> 4, c8 = sl & 15;
        const int tt = 64 * j + 13 + r, ttc = tt < 0 ? 0 : tt;
        const bf16* rowp = (j == CH1 && ttc < 64 * CH1 + 16) ? CSAVE + (size_t)(n * 3 + (ttc - (64 * CH1 + 13))) * 3072 : QKV + (size_t)(n * TP + ttc) * 3072;
        L.stg[k] = LDNT((const v4u*)(rowp + arr * 1024 + h * 128 + 8 * c8)); }
    L.ba0 = 0.f; L.ba1 = 0.f;
    if (sub == 0 && t >= 0) { const float* ba = BA + (size_t)(n * TP + t) * 16; L.ba0 = ba[h]; L.ba1 = ba[8 + h]; }
#pragma unroll
    for (int k = 0; k < 3; ++k) { const int q = tid + 512 * k, tap = q / 384, c = q - tap * 384; L.cw[k] = a.in[17][tap * 3072 + (c >> 7) * 1024 + h * 128 + (c & 127)]; }
}
template <bool VIRT> __device__ __forceinline__ int pre_core(const Ctx& C, const Args& a, int n, int h, int j, unsigned char* rec, int jbase, int nitems, int qid, PreLd& L) {
    int tid = ((int)threadIdx.x); asm volatile("" : "+v"(tid)); const int lane = tid & 63, w = C.wave;
    LAS unsigned char* lds = C.lds;
    bf16* CSAVE = (bf16*)(a.ws + WS_CSAVE);
    LAS float* SC = (LAS float*)(lds + L_SC);
    unsigned tk = 0u; if (!VIRT && tid == 0) tk = __hip_atomic_fetch_add((unsigned*)(C.ctl + CW_Q + 64 * qid), 1u, RLX_AGENT);
    const int i = tid >> 3, sub = tid & 7, d0 = 16 * sub;
    const int t = 64 * j + 16 + i; const bool valid = t >= 0;
    LAS float* CW = (LAS float*)(lds + L_CW);
    constexpr int RAW_LD = 784;
    const float ba0 = L.ba0, ba1 = L.ba1;
#pragma unroll
    for (int k = 0; k < 3; ++k) CW[tid + 512 * k] = L.cw[k];
#pragma unroll
    for (int k = 0; k < 7; ++k) { const int p = tid + 512 * k, r = p / 48, sl = p - 48 * r; v4u x = L.stg[k]; if (64 * j + 13 + r < 0) x = (v4u){0u, 0u, 0u, 0u};
        if (p < 3216) *(LAS v4u*)(lds + r * RAW_LD + sl * 16) = x; }
    __syncthreads();
    float qv[16], kv[16], vv[16];
#pragma unroll
    for (int arr = 0; arr < 3; ++arr) {
        float acc[16];
#pragma unroll
        for (int e = 0; e < 16; ++e) acc[e] = 0.f;
        const int c0 = arr * 1024 + h * 128 + d0;
#pragma unroll
        for (int tap = 0; tap < 4; ++tap) {
            const LAS v4u* rp = (const LAS v4u*)(lds + (i + tap) * RAW_LD + arr * 256 + sub * 32);
            const v4u r0 = rp[0], r1 = rp[1];
            const LAS float* cw = CW + tap * 384 + arr * 128 + d0;
            const f32x4 w0 = *(const LAS f32x4*)cw, w1 = *(const LAS f32x4*)(cw + 4), w2 = *(const LAS f32x4*)(cw + 8), w3 = *(const LAS f32x4*)(cw + 12);
            acc[0] += w0.x * bflo(r0.x); acc[1] += w0.y * bfhi(r0.x); acc[2] += w0.z * bflo(r0.y); acc[3] += w0.w * bfhi(r0.y);
            acc[4] += w1.x * bflo(r0.z); acc[5] += w1.y * bfhi(r0.z); acc[6] += w1.z * bflo(r0.w); acc[7] += w1.w * bfhi(r0.w);
            acc[8] += w2.x * bflo(r1.x); acc[9] += w2.y * bfhi(r1.x); acc[10] += w2.z * bflo(r1.y); acc[11] += w2.w * bfhi(r1.y);
            acc[12] += w3.x * bflo(r1.z); acc[13] += w3.y * bfhi(r1.z); acc[14] += w3.z * bflo(r1.w); acc[15] += w3.w * bfhi(r1.w);
            if (!VIRT && tap == 3 && valid) {
                if (j == CH1 - 1 && i >= 61) { bf16* dst = CSAVE + (size_t)(n * 3 + (i - 61)) * 3072 + c0; *(v4u*)dst = r0; *(v4u*)(dst + 8) = r1; }
                if (j == NCH - 1 && i >= 61) { float* dst = a.out + O_PCONV + (size_t)(n * 3 + (i - 61)) * 3072 + c0;
                    *(f32x4*)dst = (f32x4){bflo(r0.x), bfhi(r0.x), bflo(r0.y), bfhi(r0.y)}; *(f32x4*)(dst + 4) = (f32x4){bflo(r0.z), bfhi(r0.z), bflo(r0.w), bfhi(r0.w)};
                    *(f32x4*)(dst + 8) = (f32x4){bflo(r1.x), bfhi(r1.x), bflo(r1.y), bfhi(r1.y)}; *(f32x4*)(dst + 12) = (f32x4){bflo(r1.z), bfhi(r1.z), bflo(r1.w), bfhi(r1.w)}; }
            }
        }
        float ss = 0.f;
#pragma unroll
        for (int e = 0; e < 16; ++e) { acc[e] = siluf_(acc[e]); ss += acc[e] * acc[e]; }
        if (arr < 2) { ss += xl1(ss); ss += xl2(ss); ss += xh4(ss);
            const float rs = rsqrtf(ss + L2_EPS) * (arr == 0 ? 0.08838834764831845f : 1.0f);
#pragma unroll
            for (int e = 0; e < 16; ++e) acc[e] *= rs; }
#pragma unroll
        for (int e = 0; e < 16; ++e) { if (arr == 0) qv[e] = acc[e]; else if (arr == 1) kv[e] = acc[e]; else vv[e] = acc[e]; }
    }
    if (sub == 0) {
        float beta = 0.f, g = 0.f;
        if (valid) { beta = sigmoidf_(ba0);
            const float x = ba1 + a.in[19][h]; const float sp = x > 20.f ? x : log1pf(__expf(x)); g = -__expf(a.in[18][h]) * sp; }
        SC[i] = beta; SC[64 + i] = g;
    }
    __syncthreads();
    if (w == 0) { float v = SC[64 + lane];
#pragma unroll
        for (int o = 1; o < 64; o <<= 1) { const float u = __shfl_up(v, o); if (lane >= o) v += u; }
        SC[128 + lane] = v; }
    __syncthreads();
    {
        const float gci = SC[128 + i], gcl = SC[128 + 63], bi = SC[i];
        const float eg = __expf(gci), ek = bi * eg, ed = __expf(gcl - gci);
        v4u o0, o1;
        o0.x = pk2(kv[0], kv[1]); o0.y = pk2(kv[2], kv[3]); o0.z = pk2(kv[4], kv[5]); o0.w = pk2(kv[6], kv[7]); o1.x = pk2(kv[8], kv[9]); o1.y = pk2(kv[10], kv[11]); o1.z = pk2(kv[12], kv[13]); o1.w = pk2(kv[14], kv[15]);
        *(LAS v4u*)(lds + L_KH + (i * 136 + d0) * 2) = o0; *(LAS v4u*)(lds + L_KH + (i * 136 + d0 + 8) * 2) = o1;
        o0.x = pk2(qv[0], qv[1]); o0.y = pk2(qv[2], qv[3]); o0.z = pk2(qv[4], qv[5]); o0.w = pk2(qv[6], qv[7]); o1.x = pk2(qv[8], qv[9]); o1.y = pk2(qv[10], qv[11]); o1.z = pk2(qv[12], qv[13]); o1.w = pk2(qv[14], qv[15]);
        *(LAS v4u*)(lds + L_QH + (i * 136 + d0) * 2) = o0; *(LAS v4u*)(lds + L_QH + (i * 136 + d0 + 8) * 2) = o1;
        o0.x = pk2(qv[0] * eg, qv[1] * eg); o0.y = pk2(qv[2] * eg, qv[3] * eg); o0.z = pk2(qv[4] * eg, qv[5] * eg); o0.w = pk2(qv[6] * eg, qv[7] * eg);
        o1.x = pk2(qv[8] * eg, qv[9] * eg); o1.y = pk2(qv[10] * eg, qv[11] * eg); o1.z = pk2(qv[12] * eg, qv[13] * eg); o1.w = pk2(qv[14] * eg, qv[15] * eg);
        if (!VIRT) { bf16* qd = (bf16*)(rec + R_QD) + i * 128 + d0; *(v4u*)qd = o0; *(v4u*)(qd + 8) = o1; }
        const int isw = (((i >> 3) ^ sub) << 3) | (i & 7);
#pragma unroll
        for (int e = 0; e < 16; ++e) {
            *(LAS bf16*)(lds + L_KTT + ((d0 + e) * 72 + isw) * 2) = (bf16)f2bf(kv[e] * ek);
            *(LAS bf16*)(lds + L_VTT + ((d0 + e) * 72 + isw) * 2) = (bf16)f2bf(vv[e] * bi);
            *(LAS bf16*)(lds + L_KDS + ((d0 + e) * 72 + isw) * 2) = (bf16)f2bf(kv[e] * ed);
        }
    }
    if (!VIRT && tid == 0) C.MISC[16] = tk;
    __syncthreads();
    int nxt = nitems;
    if (!VIRT) { nxt = (int)C.MISC[16];
        if (nxt < nitems) { int n2, h2, j2, nh2, jl2; pre_item_of(nxt, jbase, n2, h2, j2, nh2, jl2); pre_issue(a, n2, h2, j2, L); } }
    const int fr = lane & 15, fq = lane >> 4;
#pragma unroll
    for (int it4 = 0; it4 < 4; ++it4) { const int idx = w + 8 * it4;
        const int which = idx >> 4, ti = (idx >> 2) & 3, tj = idx & 3;
        const int ii = 16 * ti + fr, jj0 = 16 * tj + 4 * fq;
        if (tj > ti) { if (which == 1) *(LAS v2u*)(lds + L_QST + (ii * 72 + jj0) * 2) = (v2u){0u, 0u}; continue; }
        f32x4 acc = (f32x4){0.f, 0.f, 0.f, 0.f};
        const int offB = which == 0 ? L_KH : L_QH;
#pragma unroll
        for (int ks = 0; ks < 4; ++ks) {
            const bf16x8 af = *(const LAS bf16x8*)(lds + L_KH + ((16 * tj + fr) * 136 + 32 * ks + 8 * fq) * 2);
            const bf16x8 bf = *(const LAS bf16x8*)(lds + offB + ((16 * ti + fr) * 136 + 32 * ks + 8 * fq) * 2);
            acc = MFMA16(af, bf, acc);
        }
        const float gci = SC[128 + ii], bi = SC[ii]; float o[4];
#pragma unroll
        for (int r = 0; r < 4; ++r) { const int jj = jj0 + r; const float dec = __expf(gci - SC[128 + jj]);
            o[r] = which == 0 ? (ii > jj ? bi * acc[r] * dec : 0.f) : (ii >= jj ? acc[r] * dec : 0.f); }
        if (which == 0) *(LAS f32x4*)(lds + L_AM + (ii * AML + jj0) * 4) = (f32x4){o[0], o[1], o[2], o[3]};
        else *(LAS v2u*)(lds + L_QST + (ii * 72 + jj0) * 2) = (v2u){pk2(o[0], o[1]), pk2(o[2], o[3])};
    }
    __syncthreads();
    {
        LAS float* AMf = (LAS float*)(lds + L_AM); LAS float* Tf = (LAS float*)(lds + L_KH); LAS float* TMP = (LAS float*)(lds + L_QH);
        const int ba = lane & 15, bcg = lane >> 4;
        if (w < 4) {
            const LAS float* Lk = AMf + (16 * w + ba) * AML + 16 * w;
            const f32x4 l0 = *(const LAS f32x4*)Lk, l1 = *(const LAS f32x4*)(Lk + 4), l2 = *(const LAS f32x4*)(Lk + 8), l3 = *(const LAS f32x4*)(Lk + 12);
            float t0 = ba == 4 * bcg ? 1.f : 0.f, t1 = ba == 4 * bcg + 1 ? 1.f : 0.f, t2 = ba == 4 * bcg + 2 ? 1.f : 0.f, t3 = ba == 4 * bcg + 3 ? 1.f : 0.f;
            BC_STEP4(0, l0, -, t0, t1, t2, t3, t0, t1, t2, t3) BC_STEP4(1, l1, -, t0, t1, t2, t3, t0, t1, t2, t3) BC_STEP4(2, l2, -, t0, t1, t2, t3, t0, t1, t2, t3)
            BC_STEP(12, -l3.x, t0, t1, t2, t3, t0, t1, t2, t3) BC_STEP(13, -l3.y, t0, t1, t2, t3, t0, t1, t2, t3) BC_STEP(14, -l3.z, t0, t1, t2, t3, t0, t1, t2, t3)
            const f32x4 tv = (f32x4){t0, t1, t2, t3};
            *(LAS f32x4*)(Tf + (16 * w + ba) * AML + 16 * w + 4 * bcg) = tv;
        }
        __syncthreads();
        if (w < 2) {
            f32x4 acc = (f32x4){0.f, 0.f, 0.f, 0.f};
            blk_mm(AMf + (32 * w + 16) * AML + 32 * w, AML, Tf + (32 * w) * AML + 32 * w, AML, acc, ba, bcg);
            *(LAS f32x4*)(TMP + w * 256 + ba * 16 + 4 * bcg) = acc;
        }
        __syncthreads();
        if (w < 2) {
            f32x4 acc = (f32x4){0.f, 0.f, 0.f, 0.f};
            blk_mm(Tf + (32 * w + 16) * AML + 32 * w + 16, AML, TMP + w * 256, 16, acc, ba, bcg);
            *(LAS f32x4*)(Tf + (32 * w + 16 + ba) * AML + 32 * w + 4 * bcg) = -acc;
        }
        __syncthreads();
        if (w < 4) {
            const int yi = w >> 1, yj = w & 1; f32x4 acc = (f32x4){0.f, 0.f, 0.f, 0.f};
            if (yj == 0) blk_mm(AMf + (32 + 16 * yi) * AML + 0, AML, Tf + 0, AML, acc, ba, bcg);
            blk_mm(AMf + (32 + 16 * yi) * AML + 16, AML, Tf + 16 * AML + 16 * yj, AML, acc, ba, bcg);
            *(LAS f32x4*)(TMP + (2 + w) * 256 + ba * 16 + 4 * bcg) = acc;
        }
        __syncthreads();
        if (w < 4) {
            const int ti = w >> 1, tj = w & 1; f32x4 acc = (f32x4){0.f, 0.f, 0.f, 0.f};
            blk_mm(Tf + (32 + 16 * ti) * AML + 32, AML, TMP + (2 + tj) * 256, 16, acc, ba, bcg);
            if (ti == 1) blk_mm(Tf + 48 * AML + 48, AML, TMP + (4 + tj) * 256, 16, acc, ba, bcg);
            *(LAS f32x4*)(Tf + (32 + 16 * ti + ba) * AML + 16 * tj + 4 * bcg) = -acc;
        }
        __syncthreads();
        {
            const int c8 = tid & 7; const bool lower = (8 * c8) / 16 <= i / 16;
            const f32x4 t0 = *(const LAS f32x4*)(Tf + i * AML + 8 * c8), t1 = *(const LAS f32x4*)(Tf + i * AML + 8 * c8 + 4);
            v4u o = (v4u){pk2(t0.x, t0.y), pk2(t0.z, t0.w), pk2(t1.x, t1.y), pk2(t1.z, t1.w)};
            if (!lower) o = (v4u){0u, 0u, 0u, 0u};
            *(LAS v4u*)(lds + L_TB + (i * 72 + 8 * c8) * 2) = o;
        }
    }
    __syncthreads();
#pragma unroll
    for (int it8 = 0; it8 < 8; ++it8) { const int idx = w + 8 * it8;
        const int which = idx >> 5, tm = (idx >> 3) & 3, tn = idx & 7;
        f32x4 acc = (f32x4){0.f, 0.f, 0.f, 0.f};
#pragma unroll
        for (int ks = 0; ks < 2; ++ks) {
            const bf16x8 tf = *(const LAS bf16x8*)(lds + L_TB + ((16 * tm + fr) * 72 + 32 * ks + 8 * fq) * 2);
            const bf16x8 xf = *(const LAS bf16x8*)(lds + (which == 0 ? L_KTT : L_VTT) + ((16 * tn + fr) * 72 + 8 * ((4 * ks + fq) ^ tn)) * 2);
            acc = which == 0 ? MFMA16(xf, tf, acc) : MFMA16(tf, xf, acc);
        }
        const v2u o = (v2u){pk2(acc[0], acc[1]), pk2(acc[2], acc[3])};
        if (which == 0) *(LAS v2u*)(lds + L_WST + ((16 * tm + fr) * 136 + 16 * tn + 4 * fq) * 2) = o;
        else *(LAS v2u*)(lds + L_UST + ((16 * tn + fr) * 68 + 16 * tm + 4 * fq) * 2) = o;
    }
    __syncthreads();
    if (!VIRT) {
#pragma unroll
    for (int s = 0; s < 2; ++s) { const int q = tid + 512 * s;
        { const int row = q >> 4, c = q & 15; *(v4u*)((bf16*)(rec + R_W) + row * 128 + 8 * c) = *(const LAS v4u*)(lds + L_WST + (row * 136 + 8 * c) * 2); }
        { const int row = q >> 3, c = q & 7; const LAS v2u* p = (const LAS v2u*)(lds + L_UST + (row * 68 + 8 * c) * 2); const v2u lo = p[0], hi = p[1];
          *(v4u*)((bf16*)(rec + R_UBT) + row * 64 + 8 * c) = (v4u){lo.x, lo.y, hi.x, hi.y}; } }
    { const int row = tid >> 3, c = tid & 7; *(v4u*)((bf16*)(rec + R_QK) + row * 64 + 8 * c) = *(const LAS v4u*)(lds + L_QST + (row * 72 + 8 * c) * 2); }
#pragma unroll
    for (int s = 0; s < 2; ++s) { const int q = tid + 512 * s, row = q >> 3, c16 = q & 7;
        *(v4u*)((bf16*)(rec + R_KDT) + row * 64 + 8 * c16) = *(const LAS v4u*)(lds + L_KDS + (row * 72 + 8 * (c16 ^ ((row >> 4) & 7))) * 2); }
    if (tid == 0) ((float*)(a.ws + WS_CDEC))[(n * 8 + h) * NCH + j] = __expf(SC[128 + 63]);
    } else {
        float* sm = (float*)(a.ws + WS_SMETA) + (size_t)h * 128 * 128;
        const int d = 16 * w + fr;
        bf16x8 kf[2];
#pragma unroll
        for (int ks = 0; ks < 2; ++ks) kf[ks] = *(const LAS bf16x8*)(lds + L_KDS + (d * 72 + 8 * ((4 * ks + fq) ^ ((d >> 4) & 7))) * 2);
#pragma unroll
        for (int te = 0; te < 8; ++te) { f32x4 acc = (f32x4){0.f, 0.f, 0.f, 0.f};
#pragma unroll
            for (int ks = 0; ks < 2; ++ks) { const LAS v2u* p = (const LAS v2u*)(lds + L_UST + ((16 * te + fr) * 68 + 32 * ks + 8 * fq) * 2); const v2u lo = p[0], hi = p[1];
                acc = MFMA16(kf[ks], __builtin_bit_cast(bf16x8, (v4u){lo.x, lo.y, hi.x, hi.y}), acc); }
#pragma unroll
            for (int r = 0; r < 4; ++r) sm[(16 * w + 4 * fq + r) * 128 + 16 * te + fr] = acc[r]; }
    }
    __syncthreads();
    return nxt;
}
__device__ __forceinline__ int dn_pre_item(const Ctx& C, const Args& a, int it, int jbase, int nitems, int qid, unsigned char* sreg, PreLd& L) {
    int n, h, j, nh, jl; pre_item_of(it, jbase, n, h, j, nh, jl);
    unsigned char* rec = sreg + SR_DNI + ((size_t)nh * CH1 + jl) * DNI_REC;
    if (j == 0 && n == 0) { PreLd V; pre_issue(a, 0, h, -1, V); (void)pre_core<true>(C, a, 0, h, -1, rec, jbase, nitems, qid, V); }
    return pre_core<false>(C, a, n, h, j, rec, jbase, nitems, qid, L);
}
constexpr int L_ST = 0, L_UT = 4352, L_OST = 10240  , L_REC = 16384, REC_LDS = 59392;
constexpr int RL_W = 0, RL_QD = 16384, RL_KDT = 32768, RL_QK = 49152, RL_UB = 57344;
constexpr int SCAN_NLD = 9;
__device__ __forceinline__ unsigned scan_src(int q, int es) {
    if (q < 2048) { const int r = (q >> 4) & 63, s_ = q & 15, qd = q >> 10; return (qd ? R_QD : R_W) + r * 256 + ((s_ ^ (r & 15)) << 4); }
    else if (q < 3072) { const int p = q - 2048, r = p >> 3, s_ = p & 7; return R_KDT + r * 128 + ((s_ ^ (r & 7)) << 4); }
    else if (q < 3584) { const int p = q - 3072, r = p >> 3, s_ = p & 7; return R_QK + r * 128 + ((s_ ^ (r & 7)) << 4); }
    else { const int p = (q - 3584) & 127; return R_UBT + (16 * es) * 128 + p * 16; }
}
__device__ __forceinline__ void glds16(const void* gsrc, unsigned lds_dst) {
    unsigned keep;
    asm volatile("s_mov_b32 %0, m0\n\ts_mov_b32 m0, %2\n\ts_nop 0\n\tglobal_load_lds_dwordx4 %1, off\n\ts_mov_b32 m0, %0" : "=&s"(keep) : "v"(gsrc), "s"(lds_dst) : "memory");
}
__device__ __forceinline__ void dn_scan_item(const Ctx& C, const Args& a, int nh, int es, int jbase, int nc, bool first_half) {
    int tid = ((int)threadIdx.x); asm volatile("" : "+v"(tid)); const int lane = tid & 63, w = C.wave, fr = lane & 15, fq = lane >> 4;
    LAS unsigned char* lds = C.lds;
    const int n = nh >> 3, h = nh & 7;
    const unsigned char* dni = (const unsigned char*)(a.out + O_SCONV) + SR_DNI + (size_t)nh * CH1 * DNI_REC;
    const float* cdec = (const float*)(a.ws + WS_CDEC) + nh * NCH + jbase;
    float* ssave = (float*)(a.ws + WS_SSAVE) + (size_t)nh * 128 * 128;
    bf16* ORAW = (bf16*)(a.ws + WS_QKV);
    if (w == 7) {
        __syncthreads(); __syncthreads();
        bf16* orow = ORAW + (size_t)(n * TP) * 3072 + h * 128 + 16 * es;
        for (int jl = 0; jl <= nc; ++jl) {
            if (jl > 0) { const int t = 64 * (jbase + jl - 1) + 16 + lane; const LAS v4u* src = (const LAS v4u*)(lds + L_OST + ((jl - 1) & 1) * 2048 + lane * 32);
                const v4u o0 = src[0], o1 = src[1];
                if (t >= 0) { v4u* dst = (v4u*)(orow + (size_t)t * 3072); STNT(o0, dst); STNT(o1, dst + 1); } }
            if (jl < nc) { __syncthreads(); __syncthreads(); }
        }
        return;
    }
    unsigned goff[SCAN_NLD];
#pragma unroll
    for (int k = 0; k < SCAN_NLD; ++k) { const int q = tid + 448 * k; goff[k] = scan_src(q < 3712 ? q : 3711, es); }
    const bool last_ok = tid + 448 * (SCAN_NLD - 1) < 3712;
    const unsigned img0 = (unsigned)(size_t)(lds + L_REC) + (unsigned)(64 * w) * 16u;
#define SCAN_DMA(J) do { const unsigned char* rp_ = dni + (size_t)(J) * DNI_REC; const unsigned ib_ = img0 + ((J) & 1) * REC_LDS; \
        _Pragma("unroll") for (int k = 0; k < SCAN_NLD - 1; ++k) glds16(rp_ + goff[k], ib_ + 448 * 16 * k); \
        if (last_ok) glds16(rp_ + goff[SCAN_NLD - 1], ib_ + 448 * 16 * (SCAN_NLD - 1)); } while (0)
#define SCAN_DMA_WAIT() asm volatile("s_waitcnt vmcnt(0)" ::: "memory")
    const int r0 = 16 * w + 4 * fq, r1 = 112 + 4 * fq;
    f32x4 S = (f32x4){0.f, 0.f, 0.f, 0.f}, S2 = (f32x4){0.f, 0.f, 0.f, 0.f};
    { const float* sin = first_half ? (const float*)(a.ws + WS_SMETA) + (size_t)h * 128 * 128 : ssave;
#pragma unroll
        for (int r = 0; r < 4; ++r) { S[r] = sin[(r0 + r) * 128 + 16 * es + fr]; if (w == 4) S2[r] = sin[(r1 + r) * 128 + 16 * es + fr]; }
    }
    LAS float* CDL = (LAS float*)(lds + L_OST + 4096);
    if (tid < nc) CDL[tid] = cdec[tid];
    asm volatile("s_waitcnt vmcnt(0)" ::: "memory");
    __syncthreads();
    *(LAS v2u*)(lds + L_ST + (fr * 136 + r0) * 2) = (v2u){pk2(S[0], S[1]), pk2(S[2], S[3])};
    if (w == 4) *(LAS v2u*)(lds + L_ST + (fr * 136 + r1) * 2) = (v2u){pk2(S2[0], S2[1]), pk2(S2[2], S2[3])};
    SCAN_DMA(0);
    SCAN_DMA_WAIT();
    __syncthreads();
    for (int jl = 0; jl < nc; ++jl) {
        const LAS unsigned char* im = lds + L_REC + (jl & 1) * REC_LDS;
        const float cd = CDL[jl];
        if (w < 4) __builtin_amdgcn_s_setprio(2);
        if (jl + 1 < nc) SCAN_DMA(jl + 1);
        bf16x8 Sf[4];
        if (w < 4) {
            const int rr = 16 * w + fr;
#pragma unroll
            for (int ks = 0; ks < 4; ++ks) Sf[ks] = *(const LAS bf16x8*)(lds + L_ST + (fr * 136 + 32 * ks + 8 * fq) * 2);
            f32x4 X = (f32x4){0.f, 0.f, 0.f, 0.f}, Xb = (f32x4){0.f, 0.f, 0.f, 0.f};
#pragma unroll
            for (int ks = 0; ks < 4; ks += 2) { X = MFMA16(*(const LAS bf16x8*)(im + RL_W + rr * 256 + (((4 * ks + fq) ^ (rr & 15)) << 4)), Sf[ks], X);
                Xb = MFMA16(*(const LAS bf16x8*)(im + RL_W + rr * 256 + (((4 * ks + 4 + fq) ^ (rr & 15)) << 4)), Sf[ks + 1], Xb); }
            X += Xb;
            const v2u ub = *(const LAS v2u*)(im + RL_UB + fr * 128 + (16 * w + 4 * fq) * 2);
            const float u0 = bflo(ub.x) - X[0], u1 = bfhi(ub.x) - X[1], u2 = bflo(ub.y) - X[2], u3 = bfhi(ub.y) - X[3];
            *(LAS v2u*)(lds + L_UT + (fr * 72 + 16 * w + 4 * fq) * 2) = (v2u){pk2(u0, u1), pk2(u2, u3)};
            __builtin_amdgcn_s_setprio(0);
        }
        __syncthreads();
        bf16x8 Uf[2], Kf[2], K2f[2], Qf[4], QKf[2];
        Uf[0] = *(const LAS bf16x8*)(lds + L_UT + (fr * 72 + 8 * fq) * 2); Uf[1] = *(const LAS bf16x8*)(lds + L_UT + (fr * 72 + 32 + 8 * fq) * 2);
        { const int rk = 16 * w + fr;
            Kf[0] = *(const LAS bf16x8*)(im + RL_KDT + rk * 128 + ((fq ^ (rk & 7)) << 4)); Kf[1] = *(const LAS bf16x8*)(im + RL_KDT + rk * 128 + (((4 + fq) ^ (rk & 7)) << 4)); }
        if (w == 4) { const int rk = 112 + fr;
            K2f[0] = *(const LAS bf16x8*)(im + RL_KDT + rk * 128 + ((fq ^ (rk & 7)) << 4)); K2f[1] = *(const LAS bf16x8*)(im + RL_KDT + rk * 128 + (((4 + fq) ^ (rk & 7)) << 4)); }
        if (w < 4) { const int rr = 16 * w + fr;
#pragma unroll
            for (int q4 = 0; q4 < 4; ++q4) Qf[q4] = *(const LAS bf16x8*)(im + RL_QD + rr * 256 + (((4 * q4 + fq) ^ (rr & 15)) << 4));
            QKf[0] = *(const LAS bf16x8*)(im + RL_QK + rr * 128 + ((fq ^ (rr & 7)) << 4)); QKf[1] = *(const LAS bf16x8*)(im + RL_QK + rr * 128 + (((4 + fq) ^ (rr & 7)) << 4)); }
        S = S * cd; if (w == 4) S2 = S2 * cd;
        asm volatile("s_waitcnt lgkmcnt(0)" ::: "memory");
        __builtin_amdgcn_sched_barrier(0);
        S = MFMA16(Kf[0], Uf[0], S);
        if (w == 4) S2 = MFMA16(K2f[0], Uf[0], S2);
        S = MFMA16(Kf[1], Uf[1], S);
        if (w == 4) S2 = MFMA16(K2f[1], Uf[1], S2);
        *(LAS v2u*)(lds + L_ST + (fr * 136 + r0) * 2) = (v2u){pk2(S[0], S[1]), pk2(S[2], S[3])};
        if (w == 4) *(LAS v2u*)(lds + L_ST + (fr * 136 + r1) * 2) = (v2u){pk2(S2[0], S2[1]), pk2(S2[2], S2[3])};
        if (w < 4) {
            f32x4 O = (f32x4){0.f, 0.f, 0.f, 0.f}, Ob = (f32x4){0.f, 0.f, 0.f, 0.f}, Oc = (f32x4){0.f, 0.f, 0.f, 0.f};
            O = MFMA16(Qf[0], Sf[0], O); Ob = MFMA16(Qf[1], Sf[1], Ob); Oc = MFMA16(QKf[0], Uf[0], Oc);
            O = MFMA16(Qf[2], Sf[2], O); Ob = MFMA16(Qf[3], Sf[3], Ob); Oc = MFMA16(QKf[1], Uf[1], Oc);
            O += Ob + Oc;
            LAS bf16* ost = (LAS bf16*)(lds + L_OST + (jl & 1) * 2048) + (16 * w + 4 * fq) * 16 + fr;
#pragma unroll
            for (int r = 0; r < 4; ++r) ost[r * 16] = (bf16)f2bf(O[r]);
        }
        SCAN_DMA_WAIT();
        __syncthreads();
    }
#undef SCAN_DMA
#undef SCAN_DMA_WAIT
    float* ps = first_half ? ssave : a.out + O_PSSM + (size_t)nh * 128 * 128;
#pragma unroll
    for (int r = 0; r < 4; ++r) { ps[(r0 + r) * 128 + 16 * es + fr] = S[r]; if (w == 4) ps[(r1 + r) * 128 + 16 * es + fr] = S2[r]; }
}
constexpr int SDN_LDS = 35840;
__device__ __forceinline__ void sdn_batch(const Ctx& C, const Args& a, int batch) {
    int tid = (int)threadIdx.x; asm volatile("" : "+v"(tid)); const int lane = tid & 63, w = C.wave;
    const int sub = tid >> 8, t8 = tid & 255, item = 2 * batch + sub, n = item >> 3, h = item & 7;
    const int e = 32 * (w & 3) + (lane & 31), dg = lane >> 5;
    LAS unsigned char* lds = C.lds + sub * SDN_LDS;
    LAS float* RAW = (LAS float*)lds; LAS float* XS = (LAS float*)(lds + 16896); LAS float* SCB = (LAS float*)(lds + 16896 + 12288); LAS float* CWS = (LAS float*)(lds + 29312);
    const bf16* QKV = (const bf16*)(a.ws + WS_QKV); const float* BA = (const float*)(a.ws + WS_BA);
    const int row0 = PROWS + n * ST;
    f32x4 hx[3]; v4u nx[3]; f32x4 cwx[2];
#pragma unroll
    for (int k = 0; k < 3; ++k) {
        const int p = t8 + 256 * k;
        if (p < 288) { const int rr = p / 96, c = (p - rr * 96) * 4, col = (c >> 7) * 1024 + h * 128 + (c & 127); hx[k] = *(const f32x4*)(a.in[2] + (size_t)(n * 3 + rr) * 3072 + col); }
        else if (p < 672) { const int q = p - 288, rn = q / 48, c = (q - rn * 48) * 8, col = (c >> 7) * 1024 + h * 128 + (c & 127); nx[k] = *(const v4u*)(QKV + (size_t)(row0 + rn) * 3072 + col); }
    }
#pragma unroll
    for (int k = 0; k < 2; ++k) { const int q = t8 + 256 * k; if (q < 384) { const int tap = q / 96, c = (q - tap * 96) * 4;
        cwx[k] = *(const f32x4*)(a.in[17] + tap * 3072 + (c >> 7) * 1024 + h * 128 + (c & 127)); } }
    float bav0 = 0.f, bav1 = 0.f;
    if (t8 < 8) { const float* ba = BA + (size_t)(row0 + t8) * 16; bav0 = ba[h]; bav1 = ba[8 + h]; }
    const float* sp = a.in[3] + (size_t)(n * 8 + h) * 16384 + (size_t)(64 * dg) * 128 + e;
    float S[64];
#pragma unroll
    for (int g = 0; g < 8; ++g) { const float* pg = sp + g * 1024; asm volatile("" : "+v"(pg));
#pragma unroll
        for (int j = 0; j < 8; ++j) S[8 * g + j] = LDNT(pg + j * 128); }
#pragma unroll
    for (int k = 0; k < 3; ++k) {
        const int p = t8 + 256 * k;
        if (p < 288) { const int rr = p / 96, c = (p - rr * 96) * 4; *(LAS f32x4*)(RAW + rr * 384 + c) = hx[k]; }
        else if (p < 672) { const int q = p - 288, rn = q / 48, c = (q - rn * 48) * 8, col = (c >> 7) * 1024 + h * 128 + (c & 127);
            const v4u wv = nx[k];
            const f32x4 x0 = (f32x4){bflo(wv.x), bfhi(wv.x), bflo(wv.y), bfhi(wv.y)}, x1 = (f32x4){bflo(wv.z), bfhi(wv.z), bflo(wv.w), bfhi(wv.w)};
            *(LAS f32x4*)(RAW + (3 + rn) * 384 + c) = x0; *(LAS f32x4*)(RAW + (3 + rn) * 384 + c + 4) = x1;
            if (rn >= 5) { float* d = a.out + O_SCONV + (size_t)(n * 3 + (rn - 5)) * 3072 + col; *(f32x4*)d = x0; *(f32x4*)(d + 4) = x1; } }
    }
#pragma unroll
    for (int k = 0; k < 2; ++k) { const int q = t8 + 256 * k; if (q < 384) { const int tap = q / 96, c = (q - tap * 96) * 4; *(LAS f32x4*)(CWS + tap * 384 + c) = cwx[k]; } }
    if (t8 < 8) { SCB[t8] = sigmoidf_(bav0);
        const float x = bav1 + a.in[19][h]; const float spv = x > 20.f ? x : log1pf(__expf(x)); SCB[8 + t8] = __expf(-__expf(a.in[18][h]) * spv); }
    __syncthreads();
#pragma unroll
    for (int k = 0; k < 12; ++k) {
        const int idx = t8 + 256 * k, t = idx / 384, c = idx - t * 384;
        float acc = 0.f;
#pragma unroll
        for (int tap = 0; tap < 4; ++tap) acc += CWS[tap * 384 + c] * RAW[(t + tap) * 384 + c];
        XS[((c >> 7) * 8 + t) * 128 + (c & 127)] = siluf_(acc);
    }
    __syncthreads();
#pragma unroll
    for (int rr = 0; rr < 4; ++rr) { const int row = 4 * (w & 3) + rr; const float x0 = XS[row * 128 + lane], x1 = XS[row * 128 + 64 + lane];
        const float rs = rsqrtf(wave_sum(x0 * x0 + x1 * x1) + L2_EPS) * (row < 8 ? 0.08838834764831845f : 1.0f);
        XS[row * 128 + lane] = x0 * rs; XS[row * 128 + 64 + lane] = x1 * rs; }
    __syncthreads();
    bf16* OS = (bf16*)(a.ws + WS_OS) + (size_t)(n * ST) * 1024 + h * 128 + e;
#pragma unroll 1
    for (int t = 0; t < ST; ++t) {
        const float dec = SCB[8 + t], beta = SCB[t];
        const LAS float* qp = XS + t * 128 + 64 * dg; const LAS float* kp = XS + (8 + t) * 128 + 64 * dg;
        float ks0 = 0.f, ks1 = 0.f;
#pragma unroll
        for (int d = 0; d < 64; d += 4) { const f32x4 kv = *(const LAS f32x4*)(kp + d);
            S[d] *= dec; S[d + 1] *= dec; S[d + 2] *= dec; S[d + 3] *= dec;
            ks0 += kv.x * S[d]; ks1 += kv.y * S[d + 1]; ks0 += kv.z * S[d + 2]; ks1 += kv.w * S[d + 3]; }
        float ks = sum_x32(ks0 + ks1);
        const float u = beta * (XS[(16 + t) * 128 + e] - ks);
        float o0 = 0.f, o1 = 0.f;
#pragma unroll
        for (int d = 0; d < 64; d += 4) { const f32x4 kv = *(const LAS f32x4*)(kp + d), qv = *(const LAS f32x4*)(qp + d);
            S[d] += kv.x * u; S[d + 1] += kv.y * u; S[d + 2] += kv.z * u; S[d + 3] += kv.w * u;
            o0 += qv.x * S[d]; o1 += qv.y * S[d + 1]; o0 += qv.z * S[d + 2]; o1 += qv.w * S[d + 3]; }
        float o = sum_x32(o0 + o1);
        if (dg == 0) __hip_atomic_store((GAS unsigned short*)(OS + (size_t)t * 1024), (unsigned short)f2bf(o), RLX_AGENT);
    }
    asm volatile("s_waitcnt vmcnt(0)" ::: "memory");
    __syncthreads();
    if (tid == 0) (void)__hip_atomic_fetch_add((unsigned*)(C.ctl + CW_SDN + 16 * n), 1u, RLX_AGENT);
    float* so = a.out + O_SSSM + (size_t)(n * 8 + h) * 16384 + (size_t)(64 * dg) * 128 + e;
#pragma unroll
    for (int g = 0; g < 8; ++g) { float* pg = so + g * 1024; asm volatile("" : "+v"(pg));
#pragma unroll
        for (int j = 0; j < 8; ++j) STNT(S[8 * g + j], pg + j * 128); }
}
__device__ __forceinline__ void state_copies(const Ctx& C, const Args& a, int part) {
    const bf16* SKV = (const bf16*)(a.ws + WS_SKV);
    int tid = (int)threadIdx.x; asm volatile("" : "+v"(tid));
    { const int n = part >> 2, isv = (part >> 1) & 1, half = part & 1;
      v4u nw = (v4u){0u, 0u, 0u, 0u}; const int nrow = half * 4 + (tid >> 5), nc = (tid & 31) * 8;
      if (tid < 128) nw = *(const v4u*)(SKV + (size_t)(PROWS + n * ST + nrow) * 512 + isv * 256 + nc);
      const int pv = part * 72 + (tid < 72 ? tid : 0), c8 = pv & 63, rw = (pv >> 6) % 144, pn = pv / (144 * 64);
      const int pt = rw < 16 ? rw : TP - 128 + (rw - 16);
      v4u pw = (v4u){0u, 0u, 0u, 0u};
      if (tid < 72) pw = *(const v4u*)(SKV + (size_t)(pn * TP + pt) * 512 + 8 * c8);
      if (tid < 128) { float* d = a.out + (isv ? O_SWV : O_SWK) + (size_t)(n * 128 + 120 + nrow) * 256 + nc;
          STNT((f32x4){bflo(nw.x), bfhi(nw.x), bflo(nw.y), bfhi(nw.y)}, (f32x4*)d); STNT((f32x4){bflo(nw.z), bfhi(nw.z), bflo(nw.w), bfhi(nw.w)}, (f32x4*)(d + 4)); }
      if (tid < 72) { const int pisv = c8 >> 5, cc = (c8 & 31) * 8;
          float* d = rw < 16 ? a.out + (pisv ? O_PMV : O_PMK) + (size_t)(pn * 16 + rw) * 256 + cc : a.out + (pisv ? O_PWV : O_PWK) + (size_t)(pn * 128 + (rw - 16)) * 256 + cc;
          STNT((f32x4){bflo(pw.x), bfhi(pw.x), bflo(pw.y), bfhi(pw.y)}, (f32x4*)d); STNT((f32x4){bflo(pw.z), bfhi(pw.z), bflo(pw.w), bfhi(pw.w)}, (f32x4*)(d + 4)); }
    }
}
constexpr int L_KL = 0, L_STG = 117504  , L_VT = 56576, VT_LD = 136  , KL_LD = 136;
constexpr float LOG2E = 1.44269504089f;

template <bool SAMPLE> __device__ __forceinline__ void swa_item(const Ctx& C, const Args& a, int n, int kvh, int jb) {
    constexpr int QT = SAMPLE ? 1 : 2, NKT = SAMPLE ? 10 : 13, NKS = SAMPLE ? 5 : 7, NKEYS = SAMPLE ? 160 : 224;
    int tid = ((int)threadIdx.x); asm volatile("" : "+v"(tid)); const int lane = tid & 63, w = C.wave, fr = lane & 15, fq = lane >> 4;
    LAS unsigned char* lds = C.lds;
    const bf16* SKV = (const bf16*)(a.ws + WS_SKV); const bf16* SQ = (const bf16*)(a.ws + WS_SQ);
    const int q_start = 64 * jb + 16;
    constexpr int NCHK = NKEYS * 16 / 512;
    v4u kws[NCHK], vws[NCHK];
    f32x4 kf0[NCHK], kf1[NCHK], vf0[NCHK], vf1[NCHK];
    if (!SAMPLE) {
#pragma unroll
        for (int s = 0; s < NCHK; ++s) { const int q = tid + 512 * s, key = q >> 4, c8 = q & 15;
            int pos = key < 16 ? key : q_start - 128 + (key - 16); const bool ok = key < 208 && pos >= 0; pos = ok ? pos : 0;
            const bf16* p = SKV + (size_t)(n * TP + pos) * 512 + kvh * 128 + 8 * c8; kws[s] = *(const v4u*)p; vws[s] = *(const v4u*)(p + 256);
            if (!ok) { kws[s] = (v4u){0u, 0u, 0u, 0u}; vws[s] = (v4u){0u, 0u, 0u, 0u}; } }
    } else {
#pragma unroll
        for (int s = 0; s < NCHK; ++s) { const int q = tid + 512 * s, key = q >> 4, c8 = q & 15;
            if (key < 144) {
                const size_t o = key < 16 ? ((size_t)(n * 16 + key) * 2 + kvh) * 128 + 8 * c8 : ((size_t)(n * 128 + (key - 16)) * 2 + kvh) * 128 + 8 * c8;
                const float* kp = (key < 16 ? a.in[4] : a.in[6]) + o; const float* vp = (key < 16 ? a.in[5] : a.in[7]) + o;
                const f32x4 k0 = LDNT((const f32x4*)kp), k1 = LDNT((const f32x4*)(kp + 4)), v0 = LDNT((const f32x4*)vp), v1 = LDNT((const f32x4*)(vp + 4));
                kws[s] = (v4u){pk2(k0.x, k0.y), pk2(k0.z, k0.w), pk2(k1.x, k1.y), pk2(k1.z, k1.w)}; vws[s] = (v4u){pk2(v0.x, v0.y), pk2(v0.z, v0.w), pk2(v1.x, v1.y), pk2(v1.z, v1.w)};
                kf0[s] = k0; kf1[s] = k1; vf0[s] = v0; vf1[s] = v1;
            } else { const int kn = key < 152 ? key - 144 : 0;
                const bf16* p = SKV + (size_t)(PROWS + n * ST + kn) * 512 + kvh * 128 + 8 * c8; kws[s] = *(const v4u*)p; vws[s] = *(const v4u*)(p + 256);
                if (key >= 152) { kws[s] = (v4u){0u, 0u, 0u, 0u}; vws[s] = (v4u){0u, 0u, 0u, 0u}; } } }
    }
    bf16x8 Qall[QT][4];
#pragma unroll
    for (int qt = 0; qt < QT; ++qt) { int hq0, rowq0;
        if (!SAMPLE) { hq0 = kvh * 4 + (w >> 1); const int pq = q_start + 32 * (w & 1) + 16 * qt + fr; rowq0 = n * TP + (pq >= 0 ? pq : 0); }
        else { hq0 = kvh * 4 + 2 * (w & 1) + (fr >> 3); rowq0 = PROWS + n * ST + (fr & 7); }
#pragma unroll
        for (int ks = 0; ks < 4; ++ks) Qall[qt][ks] = LDNT((const bf16x8*)(SQ + ((unsigned)rowq0 * 1024u + hq0 * 128 + 32 * ks + 8 * fq))); }
#pragma unroll
    for (int s = 0; s < NCHK; ++s) { const int q = tid + 512 * s, key = q >> 4, c8 = q & 15; const v4u kw = kws[s], vw = vws[s];
        if (key < 208) *(LAS v4u*)(lds + L_KL + (key * KL_LD + 8 * c8) * 2) = kw;
        *(LAS v4u*)(lds + L_VT + (key * VT_LD + 8 * c8) * 2) = vw;
    }
    if (SAMPLE) {
#pragma unroll
        for (int s = 0; s < NCHK; ++s) { const int q = tid + 512 * s, key = q >> 4, c8 = q & 15;
            if (key >= 24 && key < 144) { const size_t o = ((size_t)(n * 128 + (key - 24)) * 2 + kvh) * 128 + 8 * c8;
                float* dk = a.out + O_SWK + o; float* dv = a.out + O_SWV + o;
                STNT(kf0[s], (f32x4*)dk); STNT(kf1[s], (f32x4*)(dk + 4)); STNT(vf0[s], (f32x4*)dv); STNT(vf1[s], (f32x4*)(dv + 4)); } }
    }
    __syncthreads();
    if (SAMPLE && w >= 2) return;
#pragma unroll 1
    for (int qt = 0; qt < QT; ++qt) {
    int hq, posq, rowq; bool okq; int zo = 0; asm volatile("" : "+v"(zo));
    if (!SAMPLE) { hq = kvh * 4 + (w >> 1); posq = q_start + 32 * (w & 1) + 16 * qt + fr; okq = posq >= 0; rowq = n * TP + (okq ? posq : 0); }
    else { hq = kvh * 4 + 2 * w + (fr >> 3); posq = fr & 7; okq = true; rowq = PROWS + n * ST + (fr & 7); }
    bf16x8 Qf[4];
#pragma unroll
    for (int ks = 0; ks < 4; ++ks) Qf[ks] = (QT > 1 && qt) ? Qall[QT - 1][ks] : Qall[0][ks];
    f32x4 sc[NKT];
#pragma unroll
    for (int kt = 0; kt < NKT; ++kt) {
        f32x4 acc = (f32x4){0.f, 0.f, 0.f, 0.f}, acb = (f32x4){0.f, 0.f, 0.f, 0.f};
#pragma unroll
        for (int ks = 0; ks < 4; ks += 2) { acc = MFMA16(*(const LAS bf16x8*)(lds + zo + L_KL + ((16 * kt + fr) * KL_LD + 32 * ks + 8 * fq) * 2), Qf[ks], acc);
            acb = MFMA16(*(const LAS bf16x8*)(lds + zo + L_KL + ((16 * kt + fr) * KL_LD + 32 * ks + 32 + 8 * fq) * 2), Qf[ks + 1], acb); }
        sc[kt] = acc + acb; if (kt & 1) __builtin_amdgcn_sched_barrier(0);
    }
    unsigned P[NKT][2];
    {
        const float slope2 = exp2f(-(float)(hq + 1)) * LOG2E, sink2 = a.in[21][hq + zo] * LOG2E, scale2 = 0.08838834764831845f * LOG2E;
        float mx = sink2;
        int bd, md0, kmin;
        if (!SAMPLE) { bd = posq - q_start + 144 - 4 * fq; md0 = posq - 4 * fq; kmin = 160 - q_start - 4 * fq; }
        else { bd = 144 + posq - 4 * fq; md0 = 0; kmin = -1000; }
#pragma unroll
        for (int kt = 0; kt < NKT; ++kt)
#pragma unroll
            for (int r = 0; r < 4; ++r) {
                int dist; bool vis;
                if (kt == 0) { if (!SAMPLE) { dist = md0 - r; vis = dist >= 0; dist = dist < 128 ? dist : 128; } else { dist = 128; vis = true; } }
                else if (!SAMPLE) { dist = bd - (16 * kt + r); vis = (unsigned)dist <= 128u && (16 * kt + r) >= kmin; }
                else if (kt < 9) { dist = bd - (16 * kt + r); vis = dist <= 128; }
                else { dist = posq - (16 * kt + r - 144) - 4 * fq; vis = dist >= 0 && (16 * kt + r + 4 * fq) < 152; }
                const float l2 = vis ? sc[kt][r] * scale2 - slope2 * (float)dist : -INFINITY;
                sc[kt][r] = l2; mx = fmaxf(mx, l2);
            }
        mx = max_x32(max_x16(mx));
        float sum = 0.f;
#pragma unroll
        for (int kt = 0; kt < NKT; ++kt)
#pragma unroll
            for (int r = 0; r < 4; ++r) { const float p = exp2f(sc[kt][r] - mx); sc[kt][r] = p; sum += p; }
        sum = sum_x32(sum_x16(sum));
        const float inv = 1.0f / (sum + exp2f(sink2 - mx));
#pragma unroll
        for (int kt = 0; kt < NKT; ++kt) { P[kt][0] = pk2(sc[kt][0] * inv, sc[kt][1] * inv); P[kt][1] = pk2(sc[kt][2] * inv, sc[kt][3] * inv); }
    }
    f32x4 O[8];
#pragma unroll
    for (int dt = 0; dt < 8; ++dt) O[dt] = (f32x4){0.f, 0.f, 0.f, 0.f};
#pragma unroll
    for (int s = 0; s < NKS; ++s) {
        v4u pw; pw.x = P[2 * s][0]; pw.y = P[2 * s][1];
        if (2 * s + 1 < NKT) { pw.z = P[2 * s + 1][0]; pw.w = P[2 * s + 1][1]; } else { pw.z = 0u; pw.w = 0u; }
        const bf16x8 Pf = __builtin_bit_cast(bf16x8, pw);
#pragma unroll
        for (int dt = 0; dt < 8; ++dt) {
            const LAS unsigned char* vp = lds + zo + L_VT + ((32 * s + 4 * fq + (fr >> 2)) * VT_LD + 16 * dt + 4 * (fr & 3)) * 2;
            typedef short s16x4 __attribute__((ext_vector_type(4)));
            const s16x4 lo = __builtin_amdgcn_ds_read_tr16_b64_v4i16((LAS s16x4*)vp), hi = __builtin_amdgcn_ds_read_tr16_b64_v4i16((LAS s16x4*)(vp + 16 * VT_LD * 2));
            const bf16x8 Vf = (bf16x8){lo[0], lo[1], lo[2], lo[3], hi[0], hi[1], hi[2], hi[3]};
            O[dt] = MFMA16(Vf, Pf, O[dt]);
        }
    }
    {
        LAS unsigned char* stg = lds + L_STG + w * 4352;
#pragma unroll
        for (int dt = 0; dt < 8; ++dt) *(LAS v2u*)(stg + (fr * 136 + 16 * dt + 4 * fq) * 2) = (v2u){pk2(O[dt][0], O[dt][1]), pk2(O[dt][2], O[dt][3])};
        asm volatile("s_waitcnt lgkmcnt(0)" ::: "memory");
        const bf16* ORAW = SAMPLE ? (const bf16*)(a.ws + WS_OS) : (const bf16*)(a.ws + WS_QKV); bf16* GD = (bf16*)(a.ws + WS_GD); const bf16* GS = (const bf16*)(a.ws + WS_GS);
        const int rr = lane >> 4, ch = lane & 15;
        const f32x4 nw0 = *(const f32x4*)(a.in[20] + zo + 8 * ch), nw1 = *(const f32x4*)(a.in[20] + zo + 8 * ch + 4);
        v4u owA[4], gdA[4], gsA[4]; unsigned c1A[4]; bool okA[4];
#pragma unroll
        for (int g = 0; g < 4; ++g) {
            const int qi = 4 * g + rr; int hq2, row2; bool ok2;
            if (!SAMPLE) { hq2 = kvh * 4 + (w >> 1); const int p2 = q_start + 32 * (w & 1) + 16 * qt + qi; ok2 = p2 >= 0; row2 = n * TP + (ok2 ? p2 : 0); }
            else { hq2 = kvh * 4 + 2 * w + (qi >> 3); ok2 = true; row2 = PROWS + n * ST + (qi & 7); }
            const unsigned c1 = (unsigned)row2 * 1024u + hq2 * 128 + 8 * ch, c3 = SAMPLE ? (unsigned)(row2 - PROWS) * 1024u + hq2 * 128 + 8 * ch : (unsigned)row2 * 3072u + hq2 * 128 + 8 * ch;
            owA[g] = LDNT((const v4u*)(ORAW + c3)); gdA[g] = LDNT((const v4u*)(GD + c1)); gsA[g] = LDNT((const v4u*)(GS + c1)); c1A[g] = c1; okA[g] = ok2;
        }
#pragma unroll
        for (int g = 0; g < 4; ++g) {
            const int qi = 4 * g + rr; const v4u ow = owA[g], gdw = gdA[g], gsw = gsA[g];
            const v4u sw = *(const LAS v4u*)(stg + (qi * 136 + 8 * ch) * 2);
            float od[8] = {bflo(ow.x), bfhi(ow.x), bflo(ow.y), bfhi(ow.y), bflo(ow.z), bfhi(ow.z), bflo(ow.w), bfhi(ow.w)};
            float ss = 0.f;
#pragma unroll
            for (int i = 0; i < 8; ++i) ss += od[i] * od[i];
            ss = row_sum16(ss);
            const float rstd = rsqrtf(ss * (1.f / 128.f) + RMS_EPS);
            const float gd[8] = {bflo(gdw.x), bfhi(gdw.x), bflo(gdw.y), bfhi(gdw.y), bflo(gdw.z), bfhi(gdw.z), bflo(gdw.w), bfhi(gdw.w)};
            const float gs[8] = {bflo(gsw.x), bfhi(gsw.x), bflo(gsw.y), bfhi(gsw.y), bflo(gsw.z), bfhi(gsw.z), bflo(gsw.w), bfhi(gsw.w)};
            const float os[8] = {bflo(sw.x), bfhi(sw.x), bflo(sw.y), bfhi(sw.y), bflo(sw.z), bfhi(sw.z), bflo(sw.w), bfhi(sw.w)};
            const float nw[8] = {nw0.x, nw0.y, nw0.z, nw0.w, nw1.x, nw1.y, nw1.z, nw1.w};
            float y[8];
#pragma unroll
            for (int i = 0; i < 8; ++i) y[i] = gd[i] * (od[i] * rstd * nw[i]) + gs[i] * os[i];
            if (okA[g]) *(v4u*)(GD + c1A[g]) = (v4u){pk2(y[0], y[1]), pk2(y[2], y[3]), pk2(y[4], y[5]), pk2(y[6], y[7])};
        }
    }
    }
}
__global__ void __launch_bounds__(NWAVES * 64, 2) hyb_fwd(Args args) {
    extern __shared__ __attribute__((aligned(16))) unsigned char lds[];
    Ctx C;
    C.lds = (LAS unsigned char*)lds; C.MISC = (volatile LAS unsigned*)(C.lds + MISC_OFF);
    C.wave = __builtin_amdgcn_readfirstlane((int)threadIdx.x >> 6);
    C.G = gridDim.x; { const int bx = blockIdx.x; C.vcu = (C.G % 8 == 0) ? (bx % 8) * (C.G / 8) + bx / 8 : bx; }
    unsigned char* ws = args.ws; C.ctl = (gu32*)(ws + WS_CTL);
    for (int u = ((int)threadIdx.x); u < (LDS_BYTES - LDSCTL_OFF) / 4; u += NWAVES * 64) ((LAS unsigned*)(C.lds + LDSCTL_OFF))[u] = 0u;
    __syncthreads();
    XcdBarrier bar; bar.bar = (unsigned*)(C.ctl + CW_BAR); bar.x = 0; bar.st = nullptr;
    if (MK_N_LAUNCHES == 1) bar = xcd_barrier_post((unsigned*)(C.ctl + CW_BAR), C.MISC + 8);
    const int lo = args.ph_lo, hi = args.ph_hi;
#define IN(k) (lo <= (k) && (k) < hi)
#define SEAM(k) do { if (IN(k) && IN((k) + 1)) xcd_barrier(bar); } while (0)
    unsigned char* sreg = (unsigned char*)(args.out + O_SCONV);
    bf16* XN1 = (bf16*)(sreg + SR_XN); bf16* W3 = (bf16*)(sreg + SR_W3); bf16* WGU1 = (bf16*)(sreg + SR_WGU1); bf16* WD1 = (bf16*)(sreg + SR_WD1);
    bf16* HID = (bf16*)(ws + WS_HID); bf16* Fb = (bf16*)(ws + WS_F); bf16* FB2 = (bf16*)(ws + WS_FB);
    pg8::SplitK SKd; SKd.init(MP, D, FF, C.G, C.vcu); pg8::SplitK SKo; SKo.init(MP, D, D, C.G, C.vcu); bf16* XN2 = (bf16*)(ws + WS_XN2); bf16* WGU2 = (bf16*)(ws + WS_WGU2); bf16* WD2 = (bf16*)(ws + WS_WD2);
    bf16* WO = (bf16*)(ws + WS_WO);

    static constexpr int REPS[NPHASE] = PROBE_REPS;
#define PHASE(k, ...) do { if (IN(k)) { _Pragma("unroll 1") for (int rp = 0; rp < REPS[k]; ++rp) { if (rp) xcd_barrier(bar); __VA_ARGS__ } } SEAM(k); } while (0)
    PHASE(0,
        { const TrJob jobs[5] = {{args.in[11], WGU1, D, FF, 1}, {args.in[12], WGU1, D, FF, 2}, {args.in[13], WD1, FF, D, 0}, {args.in[16], W3, D, DIN, 3}, {args.in[22], WO, D, D, 0}};
          transpose_jobs<5>(C, jobs); }
        { const int gt = C.vcu * (NWAVES * 64) + (int)threadIdx.x; const int NGT = C.G * NWAVES * 64; v4u* z = (v4u*)(W3 + (size_t)DIN * D);
          for (int i = gt; i < (NPROJ - DIN) * D / 8; i += NGT) z[i] = (v4u){0u, 0u, 0u, 0u}; }
        rows_norm0(C, args, args.in[9], XN1);
    );
    PHASE(1, { pg8::Gemm g{XN1, WGU1, MP, 2 * FF, D}; pg8::StaticOrder S; S.init(MP, 2 * FF, C.G, (int)blockIdx.x); pg8::EpiSwiGLU E{HID, FF};
        pg8::gemm_phase<pg8::EpiSwiGLU, pg8::StaticOrder, true, true>(C.lds, g, S, E); });
    PHASE(2, { pg8::Gemm g{HID, WD1, MP, D, FF}; pg8::EpiSplit E{Fb, FB2, D};
        pg8::gemm_phase<pg8::EpiSplit, pg8::SplitK, true, true>(C.lds, g, SKd, E); });
    PHASE(3, rows_mid<true>(C, args, Fb, FB2, SKd, args.in[10], 0.5f, args.in[14], XN1););
    PHASE(4, { pg8::Gemm g{XN1, W3, MP, NPROJ, D}; pg8::StaticOrder S; S.init(MP, NPROJ, C.G, (int)blockIdx.x);
        pg8::EpiProj E{(bf16*)(ws + WS_QKV), (bf16*)(ws + WS_SQ), (bf16*)(ws + WS_SKV), (bf16*)(ws + WS_GD), (bf16*)(ws + WS_GS), (float*)(ws + WS_BA)};
        pg8::gemm_phase<pg8::EpiProj, pg8::StaticOrder, true, true>(C.lds, g, S, E);
        { const TrJob jobs[3] = {{args.in[25], WGU2, D, FF, 1}, {args.in[26], WGU2, D, FF, 2}, {args.in[27], WD2, FF, D, 0}};
          const int nb = (transpose_total<3>(jobs) + 5 * NWAVES - 1) / (5 * NWAVES);
          for (;;) { const int b = queue_next(C, 4 + 8 * rp); if (b >= nb) break; transpose_batch<3>(C, jobs, b); } } });
#pragma unroll 1
    for (int half = 0; half < 2; ++half) {
        const int jbase = half ? CH1 : 0, nc = half ? NCH - CH1 : CH1;
        PHASE(5 + 2 * half,
            const int nitems = 32 * nc;
            int it = queue_next(C, half + 8 * rp); PreLd L;
            if (it < nitems) { int n0, h0, j0, nh0, jl0; pre_item_of(it, jbase, n0, h0, j0, nh0, jl0); pre_issue(args, n0, h0, j0, L); }
            while (it < nitems) it = dn_pre_item(C, args, it, jbase, nitems, half + 8 * rp, sreg, L);
        );
        PHASE(6 + 2 * half, for (int it = C.vcu; it < 256; it += C.G) { dn_scan_item(C, args, it >> 3, it & 7, jbase, nc, half == 0); __syncthreads(); });
    }
    PHASE(9,
        constexpr int NPI = NB * KVH * NCH, NSD = SB * NH / 2;
        static_assert(NPI >= NSD && NSD == 512 && NB * 144 * 64 == 512 * 72, "queue interleave / copy slices");
        for (;;) { const int it = queue_next(C, 3 + 8 * rp); if (it >= NPI + NSD + SB * KVH) break;
            int pi = -1, sd = -1, si = -1;
            if (it < 2 * NSD) { if (it & 1) sd = it >> 1; else pi = it >> 1; }
            else if (it < NPI + NSD) pi = it - NSD;
            else si = it - NPI - NSD;
            if (sd >= 0) { sdn_batch(C, args, sd); state_copies(C, args, sd); }
            else if (pi >= 0) { const int jb = pi % NCH, r = pi / NCH; swa_item<false>(C, args, r >> 1, r & 1, jb); }
            else { const int n = si >> 1;
                if (C.wave == 0) { gu32* cw = C.ctl + CW_SDN + 16 * n; unsigned sp = 0;
                    while ((unsigned)__builtin_amdgcn_readfirstlane(__hip_atomic_load(cw, RLX_AGENT)) < 4u) { __builtin_amdgcn_s_sleep(2); if (++sp > (1u << 22)) break; }
                    __builtin_amdgcn_fence(__ATOMIC_ACQUIRE, "agent"); asm volatile("s_waitcnt vmcnt(0)" ::: "memory"); }
                __syncthreads();
                swa_item<true>(C, args, n, si & 1, 0); } }
    );
    PHASE(11,
        pg8::Gemm g{(const bf16*)(ws + WS_GD), WO, MP, D, D}; pg8::EpiSplit E{Fb, FB2, D};
        pg8::gemm_phase<pg8::EpiSplit, pg8::SplitK, true, true>(C.lds, g, SKo, E);
    );
    PHASE(12, rows_mid<false>(C, args, Fb, FB2, SKo, args.in[15], 1.0f, args.in[23], XN2););
    PHASE(13, { pg8::Gemm g{XN2, WGU2, MP, 2 * FF, D}; pg8::StaticOrder S; S.init(MP, 2 * FF, C.G, (int)blockIdx.x); pg8::EpiSwiGLU E{HID, FF};
        pg8::gemm_phase<pg8::EpiSwiGLU, pg8::StaticOrder, true, true>(C.lds, g, S, E); });
    PHASE(14, { pg8::Gemm g{HID, WD2, MP, D, FF}; pg8::EpiSplit E{Fb, FB2, D};
        pg8::gemm_phase<pg8::EpiSplit, pg8::SplitK, true, true>(C.lds, g, SKd, E); });
    PHASE(15, rows_final(C, args, Fb, FB2, SKd, args.in[24]););
#undef PHASE
#undef IN
#undef SEAM
}

extern "C" void kernel_launch(void* const* d_in, const int* in_sizes, int n_in, void* d_out, int out_size, void* d_ws, size_t ws_size, hipStream_t stream) {
    static int grid = 0;
    if (grid == 0) {
        if (n_in != 28 || out_size != (int)O_END || ws_size < WS_END) { fprintf(stderr, "kernel_launch: unexpected shapes (n_in %d, out %d, ws %zu); nothing launched\n", n_in, out_size, ws_size); grid = -1; return; }
        int dev = 0, cus = 0, per_cu = 0;
        if (hipGetDevice(&dev) != hipSuccess || hipDeviceGetAttribute(&cus, hipDeviceAttributeMultiprocessorCount, dev) != hipSuccess) { grid = -1; return; }
        if (hipFuncSetAttribute((const void*)hyb_fwd, hipFuncAttributeMaxDynamicSharedMemorySize, LDS_BYTES) != hipSuccess) { fprintf(stderr, "kernel_launch: hipFuncSetAttribute failed\n"); grid = -1; return; }
        if (hipOccupancyMaxActiveBlocksPerMultiprocessor(&per_cu, (const void*)hyb_fwd, NWAVES * 64, LDS_BYTES) != hipSuccess || per_cu < 1)
            fprintf(stderr, "kernel_launch: note: occupancy query reports %d workgroups per CU\n", per_cu);
        (void)hipGetLastError();
        grid = cus;
    }
    if (grid < 0) return;
    if (hipMemsetAsync((char*)d_ws + WS_CTL, 0, CTL_ZERO_BYTES, stream) != hipSuccess) { fprintf(stderr, "kernel_launch: memset failed\n"); return; }
    Args a{};
    for (int i = 0; i < 28; ++i) a.in[i] = (const float*)d_in[i];
    a.out = (float*)d_out; a.ws = (unsigned char*)d_ws;
    for (int li = 0; li < MK_N_LAUNCHES; ++li) {
        a.ph_lo = (MK_N_LAUNCHES == 1) ? 0 : li; a.ph_hi = (MK_N_LAUNCHES == 1) ? NPHASE : li + 1; a.li = li;
        hipLaunchKernelGGL(hyb_fwd, dim3(grid), dim3(NWAVES * 64), LDS_BYTES, stream, a);
        const hipError_t le = hipPeekAtLastError();
        if (le != hipSuccess) { fprintf(stderr, "kernel_launch: launch %d failed: %s\n", li, hipGetErrorName(le)); break; }
    }
}
```

```cpp
#include <hip/hip_runtime.h>
#include <cstdio>
#include <cstdint>
#include <cmath>
namespace pg8 {
#define PG8_LAS __attribute__((address_space(3)))
typedef unsigned short bf16_t;
typedef short bf16x8 __attribute__((ext_vector_type(8)));
typedef float f32x4 __attribute__((ext_vector_type(4)));
typedef unsigned u32x4 __attribute__((ext_vector_type(4)));
constexpr int BM = 256, BK = 64, HALF = 128, HTB = HALF * BK * 2  , STAGE_BYTES = 8 * HTB, NXCD = 8, WGM = 8;

__host__ __device__ __forceinline__ int lds_byte(int r, int c) { const int st = (r >> 4) * 2 + (c >> 5), rr = r & 15, cc = c & 31, ob = rr * 64 + cc * 2; return st * 1024 + (ob ^ (((ob >> 9) & 1) << 5)); }
__host__ __device__ __forceinline__ void stage_rc(int b, int& R, int& C) { const int st = b / 1024, sb = b % 1024, swz = sb ^ (((sb >> 9) & 1) << 5); R = (st >> 1) * 16 + swz / 64; C = (st & 1) * 32 + (swz % 64) / 2; }
__host__ __device__ __forceinline__ int perm32(int rho) { const int n = rho >> 4, i = rho & 15; return 8 * (i >> 2) + 4 * n + (i & 3); }

struct Unit { int pm, pn, k0 = 0  , nt = 0  , tail = 0  ; };
struct Gemm { const bf16_t* A; const bf16_t* Bt; int M, N, K; };

struct StaticOrder {
    int nM, nN, nwg, G, c;
    __host__ __device__ void init(int M, int N, int G_, int c_) { nM = M / BM; nN = N / BM; nwg = nM * nN; G = G_; c = c_; }
    __host__ __device__ bool next(int i, Unit& u) const {
        const long L = (long)i * G + c; if (L >= nwg) return false;
        int wgid = (int)L; { const int q = nwg / NXCD, r = nwg % NXCD, xcd = wgid % NXCD, off = wgid / NXCD; wgid = (xcd < r ? xcd * (q + 1) : r * (q + 1) + (xcd - r) * q) + off; }
        const int nig = WGM * nN, gid = wgid / nig, fm = gid * WGM, gsz = (nM - fm) < WGM ? (nM - fm) : WGM;
        u.pm = fm + ((wgid % nig) % gsz); u.pn = (wgid % nig) / gsz; return true;
    }
    __device__ __forceinline__ void a_ready(const Unit&) const {}
    __device__ __forceinline__ void done(const Unit&) const {}
};

__device__ __forceinline__ unsigned cvt_pk_bf16(float lo, float hi) { unsigned r; asm volatile("v_cvt_pk_bf16_f32 %0, %1, %2" : "=v"(r) : "v"(lo), "v"(hi)); return r; }
struct EpiSwiGLU {
    static constexpr bool PERM = true, AFTER_DRAIN = false;
    bf16_t* O; int ldc;
    __device__ __forceinline__ void operator()(const f32x4 (&acc)[2][2][4][2], const Unit& u, int wr, int wc, int fr, int fq) const {
        const int row0 = u.pm * BM + wr * 64 + fr; const int col0 = u.pn * 128 + wc * 32 + 8 * fq;
#pragma unroll
        for (int ai = 0; ai < 2; ++ai)
#pragma unroll
            for (int m = 0; m < 4; ++m) { bf16_t* rowp = O + (size_t)(row0 + ai * HALF + m * 16) * ldc + col0; float h[8];
#pragma unroll
                for (int bj = 0; bj < 2; ++bj) { const f32x4 g = acc[ai][bj][m][0], v = acc[ai][bj][m][1];
#pragma unroll
                    for (int i = 0; i < 4; ++i) { const float e = __builtin_amdgcn_exp2f(g[i] * -1.44269504089f); h[4 * bj + i] = g[i] * __builtin_amdgcn_rcpf(1.0f + e) * v[i]; } }
                u32x4 w; w.x = cvt_pk_bf16(h[0], h[1]); w.y = cvt_pk_bf16(h[2], h[3]); w.z = cvt_pk_bf16(h[4], h[5]); w.w = cvt_pk_bf16(h[6], h[7]);
                *(u32x4*)rowp = w; }
    }
};
struct EpiPlain {
    static constexpr bool PERM = true, AFTER_DRAIN = false;
    bf16_t* O; int ldc;
    __device__ __forceinline__ void operator()(const f32x4 (&acc)[2][2][4][2], const Unit& u, int wr, int wc, int fr, int fq) const {
        const int row0 = u.pm * BM + wr * 64 + fr; const int col0 = u.pn * BM + wc * 32 + 8 * fq;
#pragma unroll
        for (int ai = 0; ai < 2; ++ai)
#pragma unroll
            for (int m = 0; m < 4; ++m) { bf16_t* rowp = O + (size_t)(row0 + ai * HALF + m * 16) * ldc + col0;
#pragma unroll
                for (int bj = 0; bj < 2; ++bj) { const f32x4 v0 = acc[ai][bj][m][0], v1 = acc[ai][bj][m][1];
                    u32x4 w; w.x = cvt_pk_bf16(v0[0], v0[1]); w.y = cvt_pk_bf16(v0[2], v0[3]); w.z = cvt_pk_bf16(v1[0], v1[1]); w.w = cvt_pk_bf16(v1[2], v1[3]);
                    *(u32x4*)(rowp + bj * HALF) = w; } }
    }
};
struct EpiProj {
    static constexpr bool PERM = true, AFTER_DRAIN = false;
    bf16_t *QKV, *SQ, *SKV, *G1, *GS; float* BA;
    __device__ __forceinline__ static float sig(float x) { return __builtin_amdgcn_rcpf(1.0f + __builtin_amdgcn_exp2f(x * -1.44269504089f)); }
    __device__ __forceinline__ void operator()(const f32x4 (&acc)[2][2][4][2], const Unit& u, int wr, int wc, int fr, int fq) const {
        const int pn = u.pn; const int row0 = u.pm * BM + wr * 64 + fr;
        if (pn == 30) {
            if (wc == 0 && fq < 2) {
#pragma unroll
                for (int ai = 0; ai < 2; ++ai)
#pragma unroll
                    for (int m = 0; m < 4; ++m) { float* rowp = BA + (size_t)(row0 + ai * HALF + m * 16) * 16 + 8 * fq;
                        *(f32x4*)(rowp) = acc[ai][0][m][0]; *(f32x4*)(rowp + 4) = acc[ai][0][m][1]; }
            }
            return;
        }
        if (pn >= 12 && pn < 20) {
            const int col0 = (pn - 12) * 128 + wc * 32 + 8 * fq;
#pragma unroll
            for (int ai = 0; ai < 2; ++ai)
#pragma unroll
                for (int m = 0; m < 4; ++m) { bf16_t* rowp = G1 + (size_t)(row0 + ai * HALF + m * 16) * 1024 + col0; float h[8];
#pragma unroll
                    for (int bj = 0; bj < 2; ++bj) { const f32x4 z = acc[ai][bj][m][0], g = acc[ai][bj][m][1];
#pragma unroll
                        for (int i = 0; i < 4; ++i) h[4 * bj + i] = z[i] * __builtin_amdgcn_rcpf((1.0f + __builtin_amdgcn_exp2f(g[i] * -1.44269504089f)) * (1.0f + __builtin_amdgcn_exp2f(z[i] * -1.44269504089f))); }
                    u32x4 w; w.x = cvt_pk_bf16(h[0], h[1]); w.y = cvt_pk_bf16(h[2], h[3]); w.z = cvt_pk_bf16(h[4], h[5]); w.w = cvt_pk_bf16(h[6], h[7]);
                    __builtin_nontemporal_store(w, (u32x4*)rowp); }
            return;
        }
        bf16_t* base; int ldc, colt; bool sg = false;
        if (pn < 12) { base = QKV; ldc = 3072; colt = pn * 256; }
        else if (pn < 24) { base = SQ; ldc = 1024; colt = (pn - 20) * 256; }
        else if (pn < 26) { base = SKV; ldc = 512; colt = (pn - 24) * 256; }
        else { base = GS; ldc = 1024; colt = (pn - 26) * 256; sg = true; }
        const int col0 = colt + wc * 32 + 8 * fq;
#pragma unroll
        for (int ai = 0; ai < 2; ++ai)
#pragma unroll
            for (int m = 0; m < 4; ++m) { bf16_t* rowp = base + (size_t)(row0 + ai * HALF + m * 16) * ldc + col0;
#pragma unroll
                for (int bj = 0; bj < 2; ++bj) { f32x4 v0 = acc[ai][bj][m][0], v1 = acc[ai][bj][m][1];
                    if (sg) { v0 = (f32x4){sig(v0[0]), sig(v0[1]), sig(v0[2]), sig(v0[3])}; v1 = (f32x4){sig(v1[0]), sig(v1[1]), sig(v1[2]), sig(v1[3])}; }
                    u32x4 w; w.x = cvt_pk_bf16(v0[0], v0[1]); w.y = cvt_pk_bf16(v0[2], v0[3]); w.z = cvt_pk_bf16(v1[0], v1[1]); w.w = cvt_pk_bf16(v1[2], v1[3]);
                    if (pn < 12) *(u32x4*)(rowp + bj * HALF) = w; else __builtin_nontemporal_store(w, (u32x4*)(rowp + bj * HALF)); } }
    }
};
struct SplitK {
    int ppu, P, G, c, pn;
    __host__ __device__ static int snap(int x, int ppu) { const int r = x % ppu; return r == 1 ? x - 1 : (r == ppu - 1 ? x + 1 : x); }
    __host__ __device__ int bound(int cc) const { return snap((cc * P) / G, ppu); }
    __host__ __device__ void init(int M, int N, int K, int G_, int c_) { const int ncol = N / BM; ppu = K / 128; P = (M / BM) * ppu; G = G_ / ncol; c = c_ / ncol; pn = c_ % ncol; }
    __host__ __device__ bool next(int i, Unit& u) const {
        int s = bound(c); const int hi = bound(c + 1);
        for (int k = 0;; ++k) { if (s >= hi) return false; const int un = s / ppu, off = s - un * ppu; int len = ppu - off; if (len > hi - s) len = hi - s;
            if (k == i) { u.pm = un; u.pn = pn; u.k0 = 2 * off; u.nt = 2 * len; u.tail = off != 0; return true; }
            s += len; }
    }
    __host__ __device__ bool has_tail(int pm) const {
        const int lo = pm * ppu, hi = lo + ppu; const int c0 = (lo * G) / P;
        for (int cc = c0 - 1; cc <= c0 + 2; ++cc) { if (cc < 1 || cc >= G) continue; const int b = bound(cc); if (b > lo && b < hi) return true; }
        return false;
    }
    __device__ __forceinline__ void a_ready(const Unit&) const {}
    __device__ __forceinline__ void done(const Unit&) const {}
};
struct EpiSplit {
    static constexpr bool PERM = true, AFTER_DRAIN = false;
    bf16_t* OA; bf16_t* OB; int ldc;
    __device__ __forceinline__ void operator()(const f32x4 (&acc)[2][2][4][2], const Unit& u, int wr, int wc, int fr, int fq) const {
        const int row0 = u.pm * BM + wr * 64 + fr; const int col0 = u.pn * BM + wc * 32 + 8 * fq; bf16_t* O = u.tail ? OB : OA;
#pragma unroll
        for (int ai = 0; ai < 2; ++ai)
#pragma unroll
            for (int m = 0; m < 4; ++m) { bf16_t* rowp = O + (size_t)(row0 + ai * HALF + m * 16) * ldc + col0;
#pragma unroll
                for (int bj = 0; bj < 2; ++bj) { const f32x4 v0 = acc[ai][bj][m][0], v1 = acc[ai][bj][m][1];
                    u32x4 w; w.x = cvt_pk_bf16(v0[0], v0[1]); w.y = cvt_pk_bf16(v0[2], v0[3]); w.z = cvt_pk_bf16(v1[0], v1[1]); w.w = cvt_pk_bf16(v1[2], v1[3]);
                    *(u32x4*)(rowp + bj * HALF) = w; } }
    }
};
template <class Epi, class Sched, bool ALIGN_EPI = false, bool SP2 = false>
__device__ __forceinline__ void gemm_phase(PG8_LAS unsigned char* lds, const Gemm g, const Sched& S, const Epi& E) {
    const int tid = threadIdx.x, wid = __builtin_amdgcn_readfirstlane(tid >> 6), lane = tid & 63, wr = wid >> 2, wc = wid & 3, fr = lane & 15, fq = lane >> 4;
    const int K = g.K;
    unsigned voffA[2], voffB[2];
#pragma unroll
    for (int i = 0; i < 2; ++i) { int R, C; stage_rc(tid * 16 + i * 8192, R, C); const int Rb = Epi::PERM ? ((R & ~31) + perm32(R & 31)) : R;
        voffA[i] = (unsigned)(R * K + C) * 2u; voffB[i] = (unsigned)(Rb * K + C) * 2u; }
    const size_t kstep = (size_t)(BK * 2);
    const size_t hstep = (size_t)HALF * K * 2;
    const size_t tstep = 2 * hstep;
    const unsigned ldsw = (unsigned)wid * 1024u;
    const int aoff = lds_byte(wr * 64 + fr, fq * 8), boff = lds_byte(wc * 32 + fr, fq * 8);
#define PG8_SA(b, h) (((b) * 2 + (h)) * HTB)
#define PG8_SB(b, h) ((4 + (b) * 2 + (h)) * HTB)
#define PG8_STAGE(bufoff, gbase, voff) do { _Pragma("unroll") for (int _i = 0; _i < 2; ++_i) \
        __builtin_amdgcn_global_load_lds((const unsigned*)((const char*)(gbase) + (voff)[_i]), (PG8_LAS unsigned*)(lds + (bufoff) + ldsw + _i * 8192), 16, 0, 0); } while (0)
#define PG8_LDA(dst, b, h) do { _Pragma("unroll") for (int m = 0; m < 4; ++m) _Pragma("unroll") for (int k = 0; k < 2; ++k) dst[m][k] = *(const PG8_LAS bf16x8*)(lds + PG8_SA(b, h) + aoff + m * 2048 + k * 1024); } while (0)
#define PG8_LDB(dst, b, h) do { _Pragma("unroll") for (int n = 0; n < 2; ++n) _Pragma("unroll") for (int k = 0; k < 2; ++k) dst[n][k] = *(const PG8_LAS bf16x8*)(lds + PG8_SB(b, h) + boff + n * 2048 + k * 1024); } while (0)
#define PG8_MMA(ai, bj, At, Bt) do { __builtin_amdgcn_s_setprio(1); _Pragma("unroll") for (int m = 0; m < 4; ++m) _Pragma("unroll") for (int n = 0; n < 2; ++n) _Pragma("unroll") for (int k = 0; k < 2; ++k) \
        acc[ai][bj][m][n] = __builtin_amdgcn_mfma_f32_16x16x32_bf16(Bt[n][k], At[m][k], acc[ai][bj][m][n], 0, 0, 0); __builtin_amdgcn_s_setprio(0); } while (0)
#define PG8_WAIT_V(n) asm volatile("s_waitcnt vmcnt(" #n ")" ::: "memory")
#define PG8_WAIT_L(n) asm volatile("s_waitcnt lgkmcnt(" #n ")" ::: "memory")
#define PG8_BAR __builtin_amdgcn_s_barrier()
#define PG8_SCHED __builtin_amdgcn_sched_barrier(0)
    Unit cur, nxt; int ui = 0;
    if (!S.next(0, cur)) return;
    f32x4 acc[2][2][4][2];
#pragma unroll
    for (int a = 0; a < 2; ++a)
#pragma unroll
        for (int b = 0; b < 2; ++b)
#pragma unroll
            for (int m = 0; m < 4; ++m)
#pragma unroll
                for (int n = 0; n < 2; ++n) acc[a][b][m][n] = (f32x4){0.f, 0.f, 0.f, 0.f};
    bf16x8 At[4][2], B0[2][2], B1[2][2];
    const char* cA = (const char*)g.A + (size_t)cur.pm * tstep + (size_t)cur.k0 * kstep; const char* cB = (const char*)g.Bt + (size_t)cur.pn * tstep + (size_t)cur.k0 * kstep;
    S.a_ready(cur);
    if constexpr (SP2) {
        PG8_STAGE(PG8_SB(0, 0), cB, voffB); PG8_STAGE(PG8_SB(0, 1), cB + hstep, voffB); PG8_STAGE(PG8_SA(0, 0), cA, voffA); PG8_STAGE(PG8_SA(0, 1), cA + hstep, voffA);
        if (wr == 1) PG8_BAR;
        PG8_WAIT_V(2); PG8_BAR;
        PG8_STAGE(PG8_SB(1, 0), cB + kstep, voffB); PG8_STAGE(PG8_SA(1, 0), cA + kstep, voffA); PG8_STAGE(PG8_SB(1, 1), cB + hstep + kstep, voffB);
        PG8_WAIT_V(6); PG8_BAR;
    } else {
        PG8_STAGE(PG8_SB(0, 0), cB, voffB); PG8_STAGE(PG8_SA(0, 0), cA, voffA); PG8_STAGE(PG8_SB(0, 1), cB + hstep, voffB); PG8_STAGE(PG8_SA(0, 1), cA + hstep, voffA);
        if (wr == 1) PG8_BAR;
        PG8_WAIT_V(4); PG8_BAR;
        PG8_STAGE(PG8_SB(1, 0), cB + kstep, voffB); PG8_STAGE(PG8_SA(1, 0), cA + kstep, voffA); PG8_STAGE(PG8_SB(1, 1), cB + hstep + kstep, voffB);
        PG8_WAIT_V(6); PG8_BAR;
    }
    for (;;) {
        const bool has_next = S.next(ui + 1, nxt);
        const char* nA = has_next ? (const char*)g.A + (size_t)nxt.pm * tstep + (size_t)nxt.k0 * kstep : cA; const char* nB = has_next ? (const char*)g.Bt + (size_t)nxt.pn * tstep + (size_t)nxt.k0 * kstep : cB;
        const int nt = cur.nt ? cur.nt : K / BK;
        for (int t = 0; t < nt; t += 2) {
            const bool last = (t == nt - 2);
            const char* a1 = cA + (size_t)(t + 1) * kstep;
            const char* a2 = last ? nA : cA + (size_t)(t + 2) * kstep; const char* b2 = last ? nB : cB + (size_t)(t + 2) * kstep;
            const char* a3 = a2 + kstep; const char* b3 = b2 + kstep;
            if (last && has_next) S.a_ready(nxt);
            if constexpr (SP2) {
            PG8_LDB(B0, 0, 0); PG8_LDB(B1, 0, 1); PG8_SCHED; PG8_LDA(At, 0, 0); PG8_STAGE(PG8_SA(1, 1), a1 + hstep, voffA);
            PG8_WAIT_V(8); PG8_WAIT_L(0); PG8_BAR; PG8_MMA(0, 0, At, B0); PG8_MMA(0, 1, At, B1); PG8_BAR; PG8_SCHED;
            PG8_LDA(At, 0, 1); PG8_STAGE(PG8_SB(0, 0), b2, voffB); PG8_STAGE(PG8_SB(0, 1), b2 + hstep, voffB); PG8_STAGE(PG8_SA(0, 0), a2, voffA);
            PG8_WAIT_V(8); PG8_WAIT_L(0); PG8_BAR; PG8_MMA(1, 0, At, B0); PG8_MMA(1, 1, At, B1); PG8_BAR; PG8_SCHED;
            PG8_LDB(B0, 1, 0); PG8_LDB(B1, 1, 1); PG8_SCHED; PG8_LDA(At, 1, 0); PG8_STAGE(PG8_SA(0, 1), a2 + hstep, voffA);
            PG8_WAIT_V(8); PG8_WAIT_L(0); PG8_BAR; PG8_MMA(0, 0, At, B0); PG8_MMA(0, 1, At, B1); PG8_BAR; PG8_SCHED;
            PG8_LDA(At, 1, 1); PG8_STAGE(PG8_SB(1, 0), b3, voffB); PG8_STAGE(PG8_SB(1, 1), b3 + hstep, voffB); PG8_STAGE(PG8_SA(1, 0), a3, voffA);
            PG8_WAIT_V(8); PG8_WAIT_L(0); PG8_BAR; PG8_MMA(1, 0, At, B0); PG8_MMA(1, 1, At, B1); PG8_BAR; PG8_SCHED;
            } else {
            PG8_LDB(B0, 0, 0); PG8_SCHED; PG8_LDA(At, 0, 0); PG8_STAGE(PG8_SA(1, 1), a1 + hstep, voffA);
            PG8_WAIT_L(8); PG8_BAR; PG8_WAIT_L(0); PG8_MMA(0, 0, At, B0); PG8_BAR; PG8_SCHED;
            PG8_LDB(B1, 0, 1); PG8_STAGE(PG8_SB(0, 0), b2, voffB);
            PG8_BAR; PG8_WAIT_L(0); PG8_MMA(0, 1, At, B1); PG8_BAR;
            PG8_LDA(At, 0, 1); PG8_STAGE(PG8_SA(0, 0), a2, voffA);
            PG8_BAR; PG8_WAIT_L(0); PG8_MMA(1, 0, At, B0); PG8_BAR; PG8_SCHED;
            PG8_STAGE(PG8_SB(0, 1), b2 + hstep, voffB);
            PG8_WAIT_V(6); PG8_BAR; PG8_MMA(1, 1, At, B1); PG8_BAR;
            PG8_LDB(B0, 1, 0); PG8_SCHED; PG8_LDA(At, 1, 0); PG8_STAGE(PG8_SA(0, 1), a2 + hstep, voffA);
            PG8_WAIT_L(8); PG8_BAR; PG8_WAIT_L(0); PG8_MMA(0, 0, At, B0); PG8_BAR; PG8_SCHED;
            PG8_LDB(B1, 1, 1); PG8_STAGE(PG8_SB(1, 0), b3, voffB);
            PG8_BAR; PG8_WAIT_L(0); PG8_MMA(0, 1, At, B1); PG8_BAR;
            PG8_LDA(At, 1, 1); PG8_STAGE(PG8_SA(1, 0), a3, voffA);
            PG8_BAR; PG8_WAIT_L(0); PG8_MMA(1, 0, At, B0); PG8_BAR; PG8_SCHED;
            PG8_STAGE(PG8_SB(1, 1), b3 + hstep, voffB);
            PG8_WAIT_V(6); PG8_BAR; PG8_MMA(1, 1, At, B1); PG8_BAR;
            }
        }
        if constexpr (ALIGN_EPI) { if (wr == 0) PG8_BAR; }
        if constexpr (!Epi::AFTER_DRAIN) { E(acc, cur, wr, wc, fr, fq); S.done(cur); }
        if (!has_next) break;
#pragma unroll
        for (int a = 0; a < 2; ++a)
#pragma unroll
            for (int b = 0; b < 2; ++b)
#pragma unroll
                for (int m = 0; m < 4; ++m)
#pragma unroll
                    for (int n = 0; n < 2; ++n) acc[a][b][m][n] = (f32x4){0.f, 0.f, 0.f, 0.f};
        cur = nxt; cA = nA; cB = nB; ++ui;
        if constexpr (ALIGN_EPI) { if (wr == 1) PG8_BAR; }
    }
    PG8_WAIT_V(0);
    if constexpr (!ALIGN_EPI) { if (wr == 0) PG8_BAR; }
    PG8_BAR;
    if constexpr (Epi::AFTER_DRAIN) { E.fused(acc, cur, wr, wc, fr, fq, lds, wid, lane); S.done(cur); }
#undef PG8_SA
#undef PG8_SB
#undef PG8_STAGE
#undef PG8_LDA
#undef PG8_LDB
#undef PG8_MMA
#undef PG8_WAIT_V
#undef PG8_WAIT_L
#undef PG8_BAR
#undef PG8_SCHED
}
}
constexpr int NWAVES = 8;
constexpr int D = 1024, FF = 2816, NB = 4, SEQ = 4096, NMETA = 16, TP = SEQ + NMETA  , PROWS = NB * TP  ;
constexpr int SB = 128, ST = 8, SROWS = SB * ST  , R = PROWS + SROWS  , MP = 17664  ;
constexpr int NH = 8, HD = 128, KVH = 2, NCH = 64  , CH1 = 32  ;
constexpr int NPROJ = 7936, DIN = 7696;
constexpr float RMS_EPS = 1e-6f, L2_EPS = 1e-6f;
constexpr int NPHASE = 16;
#ifndef PROBE_REPS
#define PROBE_REPS {1,1,1,1,1,1,1,1,1,1,1,1,1,1,1,1}
#endif
#ifndef MK_N_LAUNCHES
#define MK_N_LAUNCHES 1
#endif

constexpr size_t O_YP = 0, O_YS = 16777216, O_PCONV = 17825792, O_PSSM = 17862656, O_PMK = 18386944, O_PMV = 18403328, O_PWK = 18419712, O_PWV = 18550784,
                 O_SCONV = 18681856, O_SSSM = 19861504, O_SWK = 36638720, O_SWV = 40833024, O_END = 45027328;
constexpr size_t SR_XN = 0, SR_W3 = SR_XN + (size_t)MP * D * 2, SR_WGU1 = SR_W3 + (size_t)NPROJ * D * 2, SR_WD1 = SR_WGU1 + (size_t)2 * FF * D * 2, SR_END1 = SR_WD1 + (size_t)D * FF * 2;
constexpr size_t DNI_REC = 73728, SR_DNI = 0, SR_END2 = SR_DNI + (size_t)32 * CH1 * DNI_REC;
static_assert(SR_END1 <= (O_END - O_SCONV) * 4 && SR_END2 <= (O_END - O_SCONV) * 4, "SREG map");
constexpr size_t MiB = 1u << 20;
constexpr size_t WS_CTL = 0, CTL_ZERO_BYTES = 64 * 1024;
constexpr size_t WS_QKV = 1 * MiB, WS_Z = WS_QKV + (size_t)MP * 3072 * 2, WS_SQ = WS_Z + (size_t)MP * D * 2, WS_SKV = WS_SQ + (size_t)MP * D * 2, WS_GD = WS_SKV + (size_t)MP * 512 * 2,
                 WS_GS = WS_GD + (size_t)MP * D * 2, WS_BA = WS_GS + (size_t)MP * D * 2, WS_WO = WS_BA + (size_t)MP * 16 * 4, WS_METAH = WS_WO + (size_t)D * D * 2,
                 WS_SSAVE = WS_METAH + (size_t)NB * NMETA * D * 4, WS_CDEC = WS_SSAVE + (size_t)32 * 128 * 128 * 4, WS_CSAVE = WS_CDEC + 32 * NCH * 4 + 128  ,
                 WS_OS = WS_CSAVE + (size_t)NB * 3 * 3072 * 2  , WS_SMETA = WS_OS + (size_t)SROWS * D * 2  , WS_END = WS_SMETA + (size_t)NH * 128 * 128 * 4;
constexpr size_t WS_HID = 1 * MiB, WS_F = WS_SQ, WS_FB = WS_GS, WS_XN2 = WS_SKV, WS_WGU2 = WS_Z, WS_WD2 = WS_WGU2 + (size_t)2 * FF * D * 2, WS_OVL_END = WS_WD2 + (size_t)D * FF * 2;
static_assert(WS_HID + (size_t)MP * FF * 2 <= WS_Z && WS_OVL_END <= WS_SQ && WS_XN2 + (size_t)MP * D * 2 <= WS_GS, "FFN overlays: HID clear of the ffn2 weight copies, those inside the z slot, XN2 clear of FB");
static_assert(WS_END <= 285942368, "d_ws budget: sum of the inputs");
static_assert(WS_CDEC % 256 == 0 && WS_CSAVE % 16 == 0 && WS_BA % 256 == 0, "alignment");
constexpr int CW_Q = 64  , CW_BAR = 4096, CW_SDN = 8192  ;

constexpr int RING_BYTES = 152576  , LDSCTL_OFF = RING_BYTES, MISC_OFF = LDSCTL_OFF + 320, LDS_BYTES = 155648;

#define GAS __attribute__((address_space(1)))
#define LAS __attribute__((address_space(3)))
typedef unsigned short bf16;
typedef unsigned v4u __attribute__((ext_vector_type(4)));
typedef unsigned v2u __attribute__((ext_vector_type(2)));
typedef float f32x4 __attribute__((ext_vector_type(4)));
typedef short bf16x8 __attribute__((ext_vector_type(8)));
typedef short bf16x4 __attribute__((ext_vector_type(4)));
typedef GAS unsigned gu32;
#define RLX_AGENT __ATOMIC_RELAXED, __HIP_MEMORY_SCOPE_AGENT
#define LDS_WAIT() asm volatile("s_waitcnt lgkmcnt(0)" ::: "memory")
#define VM_WAIT() asm volatile("s_waitcnt vmcnt(0)" ::: "memory")
#define LDS_BARRIER() do { asm volatile("s_waitcnt lgkmcnt(0)" ::: "memory"); __builtin_amdgcn_s_barrier(); asm volatile("" ::: "memory"); } while (0)
#define MFMA16(a, b, c) __builtin_amdgcn_mfma_f32_16x16x32_bf16((a), (b), (c), 0, 0, 0)
typedef float f32x2_ __attribute__((ext_vector_type(2)));
typedef __bf16 bf16x2_ __attribute__((ext_vector_type(2)));
__device__ __forceinline__ unsigned pk2(float lo, float hi) { const f32x2_ v = {lo, hi}; return __builtin_bit_cast(unsigned, __builtin_convertvector(v, bf16x2_)); }
__device__ __forceinline__ unsigned f2bf(float f) { return (unsigned)__builtin_bit_cast(unsigned short, (__bf16)f); }
#define LDNT(p) __builtin_nontemporal_load(p)
template <class T> __device__ __forceinline__ void stnt_(T v, T* p) { __builtin_nontemporal_store(v, p); }
#define STNT(...) stnt_(__VA_ARGS__)
__device__ __forceinline__ float bflo(unsigned w) { return __builtin_bit_cast(float, w << 16); }
__device__ __forceinline__ float bfhi(unsigned w) { return __builtin_bit_cast(float, w & 0xffff0000u); }
__device__ __forceinline__ float bf1(bf16 h) { return __builtin_bit_cast(float, (unsigned)h << 16); }
__device__ __forceinline__ float sigmoidf_(float x) { return __builtin_amdgcn_rcpf(1.0f + __builtin_amdgcn_exp2f(x * -1.44269504089f)); }
__device__ __forceinline__ float siluf_(float x) { return x * sigmoidf_(x); }
template <int CTRL> __device__ __forceinline__ float dpp_(float v) { return __builtin_bit_cast(float, __builtin_amdgcn_update_dpp(0, __builtin_bit_cast(int, v), CTRL, 0xf, 0xf, false)); }
__device__ __forceinline__ float xl1(float v) { return dpp_<0xB1>(v); }
__device__ __forceinline__ float xl2(float v) { return dpp_<0x4E>(v); }
__device__ __forceinline__ float xr4(float v) { return dpp_<0x124>(v); }
__device__ __forceinline__ float xr8(float v) { return dpp_<0x128>(v); }
__device__ __forceinline__ float xh4(float v) { return dpp_<0x141>(v); }
__device__ __forceinline__ void plswap16(float& a, float& b) { asm("s_nop 1\n\tv_permlane16_swap_b32 %0, %1" : "+v"(a), "+v"(b)); }
__device__ __forceinline__ void plswap32(float& a, float& b) { asm("s_nop 1\n\tv_permlane32_swap_b32 %0, %1" : "+v"(a), "+v"(b)); }
__device__ __forceinline__ float sum_x16(float v) { float a = v, b = v; plswap16(a, b); return a + b; }
__device__ __forceinline__ float sum_x32(float v) { float a = v, b = v; plswap32(a, b); return a + b; }
__device__ __forceinline__ float max_x16(float v) { float a = v, b = v; plswap16(a, b); return fmaxf(a, b); }
__device__ __forceinline__ float max_x32(float v) { float a = v, b = v; plswap32(a, b); return fmaxf(a, b); }
__device__ __forceinline__ float row_sum16(float v) { v += xl1(v); v += xl2(v); v += xr4(v); v += xr8(v); return v; }
__device__ __forceinline__ float wave_sum(float v) { return sum_x32(sum_x16(row_sum16(v))); }
#define XB_TMO      128
#define XB_XCNT(j)  (256  + 64 * (j))
#define XB_XSUB(j)  (1280 + 64 * (j))
#define XB_XGEN(j)  (2304 + 64 * (j))
#define XB_TOP      3328
#define XB_TOPGEN   3392
#define XCD_BAR_WORDS 3456
#define XB_SPIN_CAP (1u << 18)

__device__ __forceinline__ unsigned xb_ld(unsigned* p)              { return __hip_atomic_load(p, __ATOMIC_RELAXED, __HIP_MEMORY_SCOPE_AGENT); }
__device__ __forceinline__ unsigned xb_add(unsigned* p, unsigned v) { return __hip_atomic_fetch_add(p, v, __ATOMIC_RELAXED, __HIP_MEMORY_SCOPE_AGENT); }
__device__ __forceinline__ unsigned xb_xcc_id() { return (unsigned)__builtin_amdgcn_s_getreg((3 << 11) | 20) & 0xFu; }
#define XB_SPIN(cond, bar) do { unsigned _sp = 0; while (cond) { __builtin_amdgcn_s_sleep(1); \
    if ((++_sp & 255u) == 0u) { if (xb_ld(&(bar)[XB_TMO])) break; if (_sp > XB_SPIN_CAP) { atomicAdd(&(bar)[XB_TMO], 1u); break; } } } } while (0)

struct XcdBarrier {
    unsigned* bar; unsigned x;
    volatile LAS unsigned* st;
};

__device__ __forceinline__ XcdBarrier xcd_barrier_post(unsigned* bar, volatile LAS unsigned* st) {
    XcdBarrier b; b.bar = bar; b.x = xb_xcc_id(); b.st = st;
    if (threadIdx.x == 0) (void)xb_add(&bar[XB_XCNT(b.x)], 1u);
    return b;
}
__device__ __forceinline__ void xcd_barrier_complete(unsigned* bar, unsigned x, unsigned& nloc, unsigned& nx) {
    const unsigned G = gridDim.x * gridDim.y * gridDim.z;
    unsigned sum, cnt, mine, sp = 0u;
    for (;;) {
        sum = 0u; cnt = 0u; mine = 0u;
#pragma unroll
        for (unsigned j = 0; j < 16; ++j) { const unsigned c = xb_ld(&bar[XB_XCNT(j)]); sum += c; cnt += (c > 0u) ? 1u : 0u; mine = (j == x) ? c : mine; }
        if (sum == G) break;
        __builtin_amdgcn_s_sleep(1);
        if ((++sp & 255u) == 0u) { if (xb_ld(&bar[XB_TMO])) break; if (sp > XB_SPIN_CAP) { atomicAdd(&bar[XB_TMO], 1u); break; } }
    }
    nloc = mine > 0u ? mine : 1u; nx = cnt > 0u ? cnt : 1u;
}

__device__ __forceinline__ void xcd_barrier(const XcdBarrier& b) {
    asm volatile("s_waitcnt vmcnt(0)" ::: "memory");
    __syncthreads();
    if (threadIdx.x == 0) {
        unsigned* bar = b.bar;
        __builtin_amdgcn_s_waitcnt(0);
        unsigned nloc = b.st[0], nx = b.st[1];
        if (nloc == 0u) { xcd_barrier_complete(bar, b.x, nloc, nx); b.st[0] = nloc; b.st[1] = nx; }
        const unsigned old = xb_add(&bar[XB_XSUB(b.x)], 1u);
        const unsigned gen = old / nloc;
        if (old + 1u == (gen + 1u) * nloc) {
            __builtin_amdgcn_fence(__ATOMIC_RELEASE, "agent");
            asm volatile("s_waitcnt vmcnt(0)" ::: "memory");
            const unsigned og = xb_add(&bar[XB_TOP], 1u);
            const unsigned tg = og / nx;
            if (og + 1u == (tg + 1u) * nx) xb_add(&bar[XB_TOPGEN], 1u);
            else XB_SPIN(xb_ld(&bar[XB_TOPGEN]) == tg, bar);
            __builtin_amdgcn_fence(__ATOMIC_ACQUIRE, "agent");
            xb_add(&bar[XB_XGEN(b.x)], 1u);
            asm volatile("s_waitcnt vmcnt(0)" ::: "memory");
        } else {
            XB_SPIN(xb_ld(&bar[XB_XGEN(b.x)]) == gen, bar);
            __builtin_amdgcn_fence(__ATOMIC_ACQUIRE, "agent");
            asm volatile("s_waitcnt vmcnt(0)" ::: "memory");
        }
    }
    __syncthreads();
}
struct Args { const float* in[28]; float* out; unsigned char* ws; int ph_lo, ph_hi, li, pad; };
struct Ctx { LAS unsigned char* lds; volatile LAS unsigned* MISC; gu32* ctl; int wave, vcu, G; };

__device__ __forceinline__ const float* h0_row(const Args& a, int r) {
    if (r >= PROWS) return a.in[1] + (size_t)(r - PROWS) * D;
    const int b = r / TP, t = r - b * TP;
    return t < NMETA ? a.in[8] + (size_t)t * D : a.in[0] + ((size_t)b * SEQ + (t - NMETA)) * D;
}
__device__ __forceinline__ float* h_row(const Args& a, int r) {
    if (r >= PROWS) return a.out + O_YS + (size_t)(r - PROWS) * D;
    const int b = r / TP, t = r - b * TP;
    return t < NMETA ? (float*)(a.ws + WS_METAH) + (size_t)(b * NMETA + t) * D : a.out + O_YP + ((size_t)b * SEQ + (t - NMETA)) * D;
}

__device__ __forceinline__ int pair_row(int h, int which) { return 128 * ((h >> 2) & 1) + 32 * (h >> 5) + 8 * ((h >> 3) & 3) + 4 * which + (h & 3); }
__device__ __forceinline__ int rowmap(int mode, int c) {
    if (mode == 1 || mode == 2) return 256 * (c >> 7) + pair_row(c & 127, mode - 1);
    if (mode == 3) {
        if (c < 3072) return c;
        if (c < 4096) { const int zc = c - 3072; return 3072 + 256 * (zc >> 7) + pair_row(zc & 127, 0); }
        if (c < 4112) return 7680 + (c - 4096);
        if (c < 5136) return 5120 + (c - 4112);
        if (c < 5648) return 6144 + (c - 5136);
        if (c < 6672) { const int gc = c - 5648; return 3072 + 256 * (gc >> 7) + pair_row(gc & 127, 1); }
        return 6656 + (c - 6672);
    }
    return c;
}
struct TrJob { const float* W; bf16* WT; int K, N, mode; };
struct TrSel { const float* W; bf16* WT; int K, N, mode, item; };
__device__ __forceinline__ void transpose_load(const TrSel& t, int lane, f32x4 (&v)[8]) {
    const int nblk = (t.N + 31) / 32, kb = t.item / nblk, nb = t.item - kb * nblk, k0 = 64 * kb, n0 = 32 * nb;
    const int cn = n0 + 4 * (lane & 7); const bool cok = cn < t.N;
    const float* src = t.W + (size_t)(k0 + (lane >> 3)) * t.N + (cok ? cn : 0);
#pragma unroll
    for (int i = 0; i < 8; ++i) v[i] = LDNT((const f32x4*)(src + (size_t)(8 * i) * t.N));
}
__device__ __forceinline__ void transpose_store(const TrSel& t, LAS float* scr, int lane, const f32x4 (&v)[8]) {
    const int nblk = (t.N + 31) / 32, kb = t.item / nblk, nb = t.item - kb * nblk, k0 = 64 * kb, n0 = 32 * nb;
    const int cn = n0 + 4 * (lane & 7); const bool cok = cn < t.N;
#pragma unroll
    for (int i = 0; i < 8; ++i) { LAS float* d = scr + (8 * i + (lane >> 3)) * 33 + 4 * (lane & 7); const f32x4 x = cok ? v[i] : (f32x4){0.f, 0.f, 0.f, 0.f};
        d[0] = x.x; d[1] = x.y; d[2] = x.z; d[3] = x.w; }
    LDS_WAIT(); asm volatile("" ::: "memory");
    const int c = lane & 7;
#pragma unroll
    for (int j = 0; j < 4; ++j) { const int n = (lane >> 3) + 8 * j; const LAS float* s = scr + (8 * c) * 33 + n;
        v4u o; o.x = pk2(s[0 * 33], s[1 * 33]); o.y = pk2(s[2 * 33], s[3 * 33]); o.z = pk2(s[4 * 33], s[5 * 33]); o.w = pk2(s[6 * 33], s[7 * 33]);
        if (n0 + n < t.N) *(v4u*)(t.WT + (size_t)rowmap(t.mode, n0 + n) * t.K + k0 + 8 * c) = o; }
    LDS_WAIT(); asm volatile("" ::: "memory");
}
template <int NJ> __device__ __forceinline__ int transpose_total(const TrJob (&jobs)[NJ]) { int total = 0;
#pragma unroll
    for (int j = 0; j < NJ; ++j) total += (jobs[j].K / 64) * ((jobs[j].N + 31) / 32);
    return total; }
template <int NJ> __device__ __forceinline__ void transpose_batch(const Ctx& C, const TrJob (&jobs)[NJ], int batch) {
    constexpr int TB = 5;
    LAS float* scr = (LAS float*)(C.lds + C.wave * 16384);
    const int lane = (int)threadIdx.x & 63, total = transpose_total<NJ>(jobs), it0 = batch * (TB * NWAVES) + C.wave;
    TrSel sel[TB]; f32x4 v[TB][8];
#pragma unroll
    for (int b = 0; b < TB; ++b) { int r = it0 + b * NWAVES < total ? it0 + b * NWAVES : 0;
        sel[b] = TrSel{jobs[0].W, jobs[0].WT, jobs[0].K, jobs[0].N, jobs[0].mode, 0};
#pragma unroll
        for (int j = 0; j < NJ; ++j) { const int nj = (jobs[j].K / 64) * ((jobs[j].N + 31) / 32);
            if (r >= 0 && r < nj) sel[b] = TrSel{jobs[j].W, jobs[j].WT, jobs[j].K, jobs[j].N, jobs[j].mode, r};
            r -= nj; }
        transpose_load(sel[b], lane, v[b]); }
#pragma unroll
    for (int b = 0; b < TB; ++b) { if (it0 + b * NWAVES >= total) break; transpose_store(sel[b], scr, lane, v[b]); }
}
template <int NJ> __device__ __forceinline__ void transpose_jobs(const Ctx& C, const TrJob (&jobs)[NJ]) {
    constexpr int TB = 5;
    LAS float* scr = (LAS float*)(C.lds + C.wave * 16384);
    const int gw = C.vcu * NWAVES + C.wave, NGW = C.G * NWAVES, lane = (int)threadIdx.x & 63;
    int total = 0;
#pragma unroll
    for (int j = 0; j < NJ; ++j) total += (jobs[j].K / 64) * ((jobs[j].N + 31) / 32);
    for (int it0 = gw; it0 < total; it0 += TB * NGW) {
        TrSel sel[TB]; f32x4 v[TB][8];
#pragma unroll
        for (int b = 0; b < TB; ++b) { int r = it0 + b * NGW < total ? it0 + b * NGW : it0;
            sel[b] = TrSel{jobs[0].W, jobs[0].WT, jobs[0].K, jobs[0].N, jobs[0].mode, 0};
#pragma unroll
            for (int j = 0; j < NJ; ++j) { const int nj = (jobs[j].K / 64) * ((jobs[j].N + 31) / 32);
                if (r >= 0 && r < nj) sel[b] = TrSel{jobs[j].W, jobs[j].WT, jobs[j].K, jobs[j].N, jobs[j].mode, r};
                r -= nj; }
            transpose_load(sel[b], lane, v[b]); }
#pragma unroll
        for (int b = 0; b < TB; ++b) { if (it0 + b * NGW >= total) break; transpose_store(sel[b], scr, lane, v[b]); }
    }
}

template <bool NT = false> __device__ __forceinline__ void store_bf16_row(bf16* orow, int lane, const f32x4 (&v)[4]) {
    unsigned long long* o8 = (unsigned long long*)orow + lane;
#pragma unroll
    for (int j = 0; j < 4; ++j) { const unsigned long long x = (unsigned long long)pk2(v[j].x, v[j].y) | ((unsigned long long)pk2(v[j].z, v[j].w) << 32);
        if (NT) STNT(x, o8 + 64 * j); else o8[64 * j] = x; }
}
__device__ __forceinline__ void load_bf16_row(const bf16* irow, int lane, f32x4 (&v)[4]) {
    const v2u* i8 = (const v2u*)irow + lane;
#pragma unroll
    for (int j = 0; j < 4; ++j) { const v2u w = i8[64 * j]; v[j] = (f32x4){bflo(w.x), bfhi(w.x), bflo(w.y), bfhi(w.y)}; }
}
__device__ __forceinline__ float sumsq4(const f32x4 (&v)[4]) {
    float s = 0.f;
#pragma unroll
    for (int j = 0; j < 4; ++j) s += (v[j].x * v[j].x + v[j].y * v[j].y) + (v[j].z * v[j].z + v[j].w * v[j].w);
    return wave_sum(s);
}
__device__ __forceinline__ void rows_norm0(const Ctx& C, const Args& a, const float* g, bf16* XN) {
    const int gw = C.vcu * NWAVES + C.wave, NGW = C.G * NWAVES;
    f32x4 gv[4];
#pragma unroll
    for (int j = 0; j < 4; ++j) gv[j] = ((const f32x4*)g)[((int)threadIdx.x & 63) + 64 * j];
    for (int r0 = gw; r0 < R; r0 += 3 * NGW) {
        f32x4 v[3][4];
#pragma unroll
        for (int b = 0; b < 3; ++b) { const int r = r0 + b * NGW < R ? r0 + b * NGW : r0; const f32x4* xr = (const f32x4*)h0_row(a, r) + ((int)threadIdx.x & 63);
#pragma unroll
            for (int j = 0; j < 4; ++j) v[b][j] = LDNT(xr + 64 * j); }
#pragma unroll
        for (int b = 0; b < 3; ++b) { const int r = r0 + b * NGW; if (r >= R) break;
            const float rs = rsqrtf(sumsq4(v[b]) * (1.f / D) + RMS_EPS);
#pragma unroll
            for (int j = 0; j < 4; ++j) v[b][j] = v[b][j] * rs * gv[j];
            store_bf16_row(XN + (size_t)r * D, ((int)threadIdx.x & 63), v[b]); }
    }
}
__device__ __forceinline__ void tail_table(const Ctx& C, const pg8::SplitK& SK) {
    LAS unsigned char* tab = C.lds;
    for (int u = (int)threadIdx.x; u < (MP / 256) * 4; u += NWAVES * 64) tab[u] = SK.has_tail(u >> 2) ? 1 : 0;
    __syncthreads();
}
constexpr int RB = 3;
struct FRaw { v2u a[4], b[4]; unsigned fl; };
__device__ __forceinline__ void f_issue(const bf16* FA, const bf16* FBp, const LAS unsigned char* tab, int r, int lane, FRaw& x) {
    const v2u* pa = (const v2u*)(FA + (size_t)r * D) + lane;
#pragma unroll
    for (int j = 0; j < 4; ++j) { x.a[j] = LDNT(pa + 64 * j); x.b[j] = (v2u){0u, 0u}; }
    x.fl = *(const LAS unsigned*)(tab + (r >> 8) * 4);
    if (x.fl) { const v2u* pb = (const v2u*)(FBp + (size_t)r * D) + lane;
#pragma unroll
        for (int j = 0; j < 4; ++j) x.b[j] = LDNT(pb + 64 * j); }
}
__device__ __forceinline__ void f_finish(const FRaw& x, f32x4 (&f)[4]) {
#pragma unroll
    for (int j = 0; j < 4; ++j) { f[j] = (f32x4){bflo(x.a[j].x), bfhi(x.a[j].x), bflo(x.a[j].y), bfhi(x.a[j].y)};
        if ((x.fl >> (8 * j)) & 1u) f[j] += (f32x4){bflo(x.b[j].x), bfhi(x.b[j].x), bflo(x.b[j].y), bfhi(x.b[j].y)}; }
}
template <bool FIRST> __device__ __forceinline__ void rows_mid(const Ctx& C, const Args& a, const bf16* Fb, const bf16* FBp, const pg8::SplitK& SK, const float* gpost, float scale, const float* gnext, bf16* XN) {
    const int gw = C.vcu * NWAVES + C.wave, NGW = C.G * NWAVES, lane = (int)threadIdx.x & 63;
    tail_table(C, SK);
    f32x4 gp[4], gn[4];
#pragma unroll
    for (int j = 0; j < 4; ++j) { gp[j] = ((const f32x4*)gpost)[lane + 64 * j]; gn[j] = ((const f32x4*)gnext)[lane + 64 * j]; }
    for (int r0 = gw; r0 < R; r0 += RB * NGW) {
        FRaw fr_[RB]; f32x4 h32[RB][4]; v2u hb[RB][4];
#pragma unroll
        for (int b = 0; b < RB; ++b) { const int r = r0 + b * NGW < R ? r0 + b * NGW : r0;
            f_issue(Fb, FBp, C.lds, r, lane, fr_[b]);
            if (FIRST) { const f32x4* hr = (const f32x4*)h0_row(a, r) + lane;
#pragma unroll
                for (int j = 0; j < 4; ++j) h32[b][j] = LDNT(hr + 64 * j); }
            else { const v2u* hp = (const v2u*)h_row(a, r) + lane;
#pragma unroll
                for (int j = 0; j < 4; ++j) hb[b][j] = LDNT(hp + 64 * j); } }
#pragma unroll
        for (int b = 0; b < RB; ++b) { const int r = r0 + b * NGW; if (r >= R) break;
            f32x4 f[4], h[4]; f_finish(fr_[b], f);
#pragma unroll
            for (int j = 0; j < 4; ++j) h[j] = FIRST ? h32[b][j] : (f32x4){bflo(hb[b][j].x), bfhi(hb[b][j].x), bflo(hb[b][j].y), bfhi(hb[b][j].y)};
            const float rs = rsqrtf(sumsq4(f) * (1.f / D) + RMS_EPS) * scale;
#pragma unroll
            for (int j = 0; j < 4; ++j) h[j] = h[j] + f[j] * rs * gp[j];
            store_bf16_row<true>((bf16*)h_row(a, r), lane, h);
            const float rs2 = rsqrtf(sumsq4(h) * (1.f / D) + RMS_EPS);
#pragma unroll
            for (int j = 0; j < 4; ++j) h[j] = h[j] * rs2 * gn[j];
            store_bf16_row(XN + (size_t)r * D, lane, h); }
    }
}
__device__ __forceinline__ void rows_final(const Ctx& C, const Args& a, const bf16* Fb, const bf16* FBp, const pg8::SplitK& SK, const float* gpost) {
    const int gw = C.vcu * NWAVES + C.wave, NGW = C.G * NWAVES, lane = (int)threadIdx.x & 63;
    tail_table(C, SK);
    f32x4 gp[4];
#pragma unroll
    for (int j = 0; j < 4; ++j) gp[j] = ((const f32x4*)gpost)[lane + 64 * j];
    for (int r0 = gw; r0 < R; r0 += RB * NGW) {
        FRaw fr_[RB]; v2u hb[RB][4];
#pragma unroll
        for (int b = 0; b < RB; ++b) { const int r = r0 + b * NGW < R ? r0 + b * NGW : r0;
            f_issue(Fb, FBp, C.lds, r, lane, fr_[b]);
            const v2u* hp = (const v2u*)h_row(a, r) + lane;
#pragma unroll
            for (int j = 0; j < 4; ++j) hb[b][j] = LDNT(hp + 64 * j); }
        asm volatile("s_waitcnt vmcnt(0)" ::: "memory");
#pragma unroll
        for (int b = 0; b < RB; ++b) { const int r = r0 + b * NGW; if (r >= R) break;
            if (r < PROWS && (r % TP) < NMETA) continue;
            f32x4 f[4]; f_finish(fr_[b], f);
            f32x4* hr = (f32x4*)h_row(a, r) + lane;
            const float rs = rsqrtf(sumsq4(f) * (1.f / D) + RMS_EPS) * 0.5f;
#pragma unroll
            for (int j = 0; j < 4; ++j) STNT((f32x4){bflo(hb[b][j].x), bfhi(hb[b][j].x), bflo(hb[b][j].y), bfhi(hb[b][j].y)} + f[j] * rs * gp[j], hr + 64 * j); }
    }
}

__device__ __forceinline__ int queue_next(const Ctx& C, int qid) {
    __syncthreads();
    if (((int)threadIdx.x) == 0) C.MISC[16] = __hip_atomic_fetch_add((unsigned*)(C.ctl + CW_Q + 64 * qid), 1u, RLX_AGENT);
    __syncthreads();
    return (int)C.MISC[16];
}
constexpr int L_KH = 0, L_QH = 17408, L_KTT = 34816, L_VTT = 53248, L_KDS = 71680, L_AM = 90112, L_TB = 107520, L_SC = 116736, L_CW = 117504, L_QST = 123648  , L_WST = 0  , L_UST = 17408  , AML = 68  ;
constexpr int R_W = 0, R_UBT = 16384, R_QD = 32768, R_KDT = 49152, R_QK = 65536;

template <int K> __device__ __forceinline__ float bc(float v) { return __builtin_bit_cast(float, __builtin_amdgcn_update_dpp(0, __builtin_bit_cast(int, v), 0x150 + K, 0xf, 0xf, false)); }
#define BC_STEP(K, AK, B0, B1, B2, B3, C0, C1, C2, C3) { const float ak_ = (AK); const float t0_ = bc<K>(B0), t1_ = bc<K>(B1), t2_ = bc<K>(B2), t3_ = bc<K>(B3); C0 += t0_ * ak_; C1 += t1_ * ak_; C2 += t2_ * ak_; C3 += t3_ * ak_; }
#define BC_STEP4(Q, AV, SGN, B0, B1, B2, B3, C0, C1, C2, C3) BC_STEP(4 * Q, SGN AV.x, B0, B1, B2, B3, C0, C1, C2, C3) BC_STEP(4 * Q + 1, SGN AV.y, B0, B1, B2, B3, C0, C1, C2, C3) \
    BC_STEP(4 * Q + 2, SGN AV.z, B0, B1, B2, B3, C0, C1, C2, C3) BC_STEP(4 * Q + 3, SGN AV.w, B0, B1, B2, B3, C0, C1, C2, C3)
__device__ __forceinline__ void blk_mm(const LAS float* A, int lda, const LAS float* B, int ldb, f32x4& acc, int a, int cg) {
#pragma unroll
    for (int ks = 0; ks < 4; ++ks) acc = __builtin_amdgcn_mfma_f32_16x16x4f32(B[(4 * ks + cg) * ldb + a], A[a * lda + 4 * ks + cg], acc, 0, 0, 0);
}

struct PreLd { v4u stg[7]; float ba0, ba1, cw[3]; };
__device__ __forceinline__ void pre_item_of(int it, int jbase, int& n, int& h, int& j, int& nh, int& jl) { jl = it / 32; nh = it - jl * 32; n = nh >> 3; h = nh & 7; j = jbase + jl; }
__device__ __forceinline__ void pre_issue(const Args& a, int n, int h, int j, PreLd& L) {
    int tid = ((int)threadIdx.x); asm volatile("" : "+v"(tid));
    const bf16* QKV = (const bf16*)(a.ws + WS_QKV); const float* BA = (const float*)(a.ws + WS_BA); const bf16* CSAVE = (const bf16*)(a.ws + WS_CSAVE);
    const int i = tid >> 3, sub = tid & 7, t = 64 * j + 16 + i;
#pragma unroll
    for (int k = 0; k < 7; ++k) { const int p = tid + 512 * k, pc = p < 3216 ? p : 3215, r = pc / 48, sl = pc - 48 * r, arr = sl >> 4, c8 = sl & 15;
        const int tt = 64 * j + 13 + r, ttc = tt < 0 ? 0 : tt;
        const bf16* rowp = (j == CH1 && ttc < 64 * CH1 + 16) ? CSAVE + (size_t)(n * 3 + (ttc - (64 * CH1 + 13))) * 3072 : QKV + (size_t)(n * TP + ttc) * 3072;
        L.stg[k] = LDNT((const v4u*)(rowp + arr * 1024 + h * 128 + 8 * c8)); }
    L.ba0 = 0.f; L.ba1 = 0.f;
    if (sub == 0 && t >= 0) { const float* ba = BA + (size_t)(n * TP + t) * 16; L.ba0 = ba[h]; L.ba1 = ba[8 + h]; }
#pragma unroll
    for (int k = 0; k < 3; ++k) { const int q = tid + 512 * k, tap = q / 384, c = q - tap * 384; L.cw[k] = a.in[17][tap * 3072 + (c >> 7) * 1024 + h * 128 + (c & 127)]; }
}
template <bool VIRT> __device__ __forceinline__ int pre_core(const Ctx& C, const Args& a, int n, int h, int j, unsigned char* rec, int jbase, int nitems, int qid, PreLd& L) {
    int tid = ((int)threadIdx.x); asm volatile("" : "+v"(tid)); const int lane = tid & 63, w = C.wave;
    LAS unsigned char* lds = C.lds;
    bf16* CSAVE = (bf16*)(a.ws + WS_CSAVE);
    LAS float* SC = (LAS float*)(lds + L_SC);
    unsigned tk = 0u; if (!VIRT && tid == 0) tk = __hip_atomic_fetch_add((unsigned*)(C.ctl + CW_Q + 64 * qid), 1u, RLX_AGENT);
    const int i = tid >> 3, sub = tid & 7, d0 = 16 * sub;
    const int t = 64 * j + 16 + i; const bool valid = t >= 0;
    LAS float* CW = (LAS float*)(lds + L_CW);
    constexpr int RAW_LD = 784;
    const float ba0 = L.ba0, ba1 = L.ba1;
#pragma unroll
    for (int k = 0; k < 3; ++k) CW[tid + 512 * k] = L.cw[k];
#pragma unroll
    for (int k = 0; k < 7; ++k) { const int p = tid + 512 * k, r = p / 48, sl = p - 48 * r; v4u x = L.stg[k]; if (64 * j + 13 + r < 0) x = (v4u){0u, 0u, 0u, 0u};
        if (p < 3216) *(LAS v4u*)(lds + r * RAW_LD + sl * 16) = x; }
    __syncthreads();
    float qv[16], kv[16], vv[16];
#pragma unroll
    for (int arr = 0; arr < 3; ++arr) {
        float acc[16];
#pragma unroll
        for (int e = 0; e < 16; ++e) acc[e] = 0.f;
        const int c0 = arr * 1024 + h * 128 + d0;
#pragma unroll
        for (int tap = 0; tap < 4; ++tap) {
            const LAS v4u* rp = (const LAS v4u*)(lds + (i + tap) * RAW_LD + arr * 256 + sub * 32);
            const v4u r0 = rp[0], r1 = rp[1];
            const LAS float* cw = CW + tap * 384 + arr * 128 + d0;
            const f32x4 w0 = *(const LAS f32x4*)cw, w1 = *(const LAS f32x4*)(cw + 4), w2 = *(const LAS f32x4*)(cw + 8), w3 = *(const LAS f32x4*)(cw + 12);
            acc[0] += w0.x * bflo(r0.x); acc[1] += w0.y * bfhi(r0.x); acc[2] += w0.z * bflo(r0.y); acc[3] += w0.w * bfhi(r0.y);
            acc[4] += w1.x * bflo(r0.z); acc[5] += w1.y * bfhi(r0.z); acc[6] += w1.z * bflo(r0.w); acc[7] += w1.w * bfhi(r0.w);
            acc[8] += w2.x * bflo(r1.x); acc[9] += w2.y * bfhi(r1.x); acc[10] += w2.z * bflo(r1.y); acc[11] += w2.w * bfhi(r1.y);
            acc[12] += w3.x * bflo(r1.z); acc[13] += w3.y * bfhi(r1.z); acc[14] += w3.z * bflo(r1.w); acc[15] += w3.w * bfhi(r1.w);
            if (!VIRT && tap == 3 && valid) {
                if (j == CH1 - 1 && i >= 61) { bf16* dst = CSAVE + (size_t)(n * 3 + (i - 61)) * 3072 + c0; *(v4u*)dst = r0; *(v4u*)(dst + 8) = r1; }
                if (j == NCH - 1 && i >= 61) { float* dst = a.out + O_PCONV + (size_t)(n * 3 + (i - 61)) * 3072 + c0;
                    *(f32x4*)dst = (f32x4){bflo(r0.x), bfhi(r0.x), bflo(r0.y), bfhi(r0.y)}; *(f32x4*)(dst + 4) = (f32x4){bflo(r0.z), bfhi(r0.z), bflo(r0.w), bfhi(r0.w)};
                    *(f32x4*)(dst + 8) = (f32x4){bflo(r1.x), bfhi(r1.x), bflo(r1.y), bfhi(r1.y)}; *(f32x4*)(dst + 12) = (f32x4){bflo(r1.z), bfhi(r1.z), bflo(r1.w), bfhi(r1.w)}; }
            }
        }
        float ss = 0.f;
#pragma unroll
        for (int e = 0; e < 16; ++e) { acc[e] = siluf_(acc[e]); ss += acc[e] * acc[e]; }
        if (arr < 2) { ss += xl1(ss); ss += xl2(ss); ss += xh4(ss);
            const float rs = rsqrtf(ss + L2_EPS) * (arr == 0 ? 0.08838834764831845f : 1.0f);
#pragma unroll
            for (int e = 0; e < 16; ++e) acc[e] *= rs; }
#pragma unroll
        for (int e = 0; e < 16; ++e) { if (arr == 0) qv[e] = acc[e]; else if (arr == 1) kv[e] = acc[e]; else vv[e] = acc[e]; }
    }
    if (sub == 0) {
        float beta = 0.f, g = 0.f;
        if (valid) { beta = sigmoidf_(ba0);
            const float x = ba1 + a.in[19][h]; const float sp = x > 20.f ? x : log1pf(__expf(x)); g = -__expf(a.in[18][h]) * sp; }
        SC[i] = beta; SC[64 + i] = g;
    }
    __syncthreads();
    if (w == 0) { float v = SC[64 + lane];
#pragma unroll
        for (int o = 1; o < 64; o <<= 1) { const float u = __shfl_up(v, o); if (lane >= o) v += u; }
        SC[128 + lane] = v; }
    __syncthreads();
    {
        const float gci = SC[128 + i], gcl = SC[128 + 63], bi = SC[i];
        const float eg = __expf(gci), ek = bi * eg, ed = __expf(gcl - gci);
        v4u o0, o1;
        o0.x = pk2(kv[0], kv[1]); o0.y = pk2(kv[2], kv[3]); o0.z = pk2(kv[4], kv[5]); o0.w = pk2(kv[6], kv[7]); o1.x = pk2(kv[8], kv[9]); o1.y = pk2(kv[10], kv[11]); o1.z = pk2(kv[12], kv[13]); o1.w = pk2(kv[14], kv[15]);
        *(LAS v4u*)(lds + L_KH + (i * 136 + d0) * 2) = o0; *(LAS v4u*)(lds + L_KH + (i * 136 + d0 + 8) * 2) = o1;
        o0.x = pk2(qv[0], qv[1]); o0.y = pk2(qv[2], qv[3]); o0.z = pk2(qv[4], qv[5]); o0.w = pk2(qv[6], qv[7]); o1.x = pk2(qv[8], qv[9]); o1.y = pk2(qv[10], qv[11]); o1.z = pk2(qv[12], qv[13]); o1.w = pk2(qv[14], qv[15]);
        *(LAS v4u*)(lds + L_QH + (i * 136 + d0) * 2) = o0; *(LAS v4u*)(lds + L_QH + (i * 136 + d0 + 8) * 2) = o1;
        o0.x = pk2(qv[0] * eg, qv[1] * eg); o0.y = pk2(qv[2] * eg, qv[3] * eg); o0.z = pk2(qv[4] * eg, qv[5] * eg); o0.w = pk2(qv[6] * eg, qv[7] * eg);
        o1.x = pk2(qv[8] * eg, qv[9] * eg); o1.y = pk2(qv[10] * eg, qv[11] * eg); o1.z = pk2(qv[12] * eg, qv[13] * eg); o1.w = pk2(qv[14] * eg, qv[15] * eg);
        if (!VIRT) { bf16* qd = (bf16*)(rec + R_QD) + i * 128 + d0; *(v4u*)qd = o0; *(v4u*)(qd + 8) = o1; }
        const int isw = (((i >> 3) ^ sub) << 3) | (i & 7);
#pragma unroll
        for (int e = 0; e < 16; ++e) {
            *(LAS bf16*)(lds + L_KTT + ((d0 + e) * 72 + isw) * 2) = (bf16)f2bf(kv[e] * ek);
            *(LAS bf16*)(lds + L_VTT + ((d0 + e) * 72 + isw) * 2) = (bf16)f2bf(vv[e] * bi);
            *(LAS bf16*)(lds + L_KDS + ((d0 + e) * 72 + isw) * 2) = (bf16)f2bf(kv[e] * ed);
        }
    }
    if (!VIRT && tid == 0) C.MISC[16] = tk;
    __syncthreads();
    int nxt = nitems;
    if (!VIRT) { nxt = (int)C.MISC[16];
        if (nxt < nitems) { int n2, h2, j2, nh2, jl2; pre_item_of(nxt, jbase, n2, h2, j2, nh2, jl2); pre_issue(a, n2, h2, j2, L); } }
    const int fr = lane & 15, fq = lane >> 4;
#pragma unroll
    for (int it4 = 0; it4 < 4; ++it4) { const int idx = w + 8 * it4;
        const int which = idx >> 4, ti = (idx >> 2) & 3, tj = idx & 3;
        const int ii = 16 * ti + fr, jj0 = 16 * tj + 4 * fq;
        if (tj > ti) { if (which == 1) *(LAS v2u*)(lds + L_QST + (ii * 72 + jj0) * 2) = (v2u){0u, 0u}; continue; }
        f32x4 acc = (f32x4){0.f, 0.f, 0.f, 0.f};
        const int offB = which == 0 ? L_KH : L_QH;
#pragma unroll
        for (int ks = 0; ks < 4; ++ks) {
            const bf16x8 af = *(const LAS bf16x8*)(lds + L_KH + ((16 * tj + fr) * 136 + 32 * ks + 8 * fq) * 2);
            const bf16x8 bf = *(const LAS bf16x8*)(lds + offB + ((16 * ti + fr) * 136 + 32 * ks + 8 * fq) * 2);
            acc = MFMA16(af, bf, acc);
        }
        const float gci = SC[128 + ii], bi = SC[ii]; float o[4];
#pragma unroll
        for (int r = 0; r < 4; ++r) { const int jj = jj0 + r; const float dec = __expf(gci - SC[128 + jj]);
            o[r] = which == 0 ? (ii > jj ? bi * acc[r] * dec : 0.f) : (ii >= jj ? acc[r] * dec : 0.f); }
        if (which == 0) *(LAS f32x4*)(lds + L_AM + (ii * AML + jj0) * 4) = (f32x4){o[0], o[1], o[2], o[3]};
        else *(LAS v2u*)(lds + L_QST + (ii * 72 + jj0) * 2) = (v2u){pk2(o[0], o[1]), pk2(o[2], o[3])};
    }
    __syncthreads();
    {
        LAS float* AMf = (LAS float*)(lds + L_AM); LAS float* Tf = (LAS float*)(lds + L_KH); LAS float* TMP = (LAS float*)(lds + L_QH);
        const int ba = lane & 15, bcg = lane >> 4;
        if (w < 4) {
            const LAS float* Lk = AMf + (16 * w + ba) * AML + 16 * w;
            const f32x4 l0 = *(const LAS f32x4*)Lk, l1 = *(const LAS f32x4*)(Lk + 4), l2 = *(const LAS f32x4*)(Lk + 8), l3 = *(const LAS f32x4*)(Lk + 12);
            float t0 = ba == 4 * bcg ? 1.f : 0.f, t1 = ba == 4 * bcg + 1 ? 1.f : 0.f, t2 = ba == 4 * bcg + 2 ? 1.f : 0.f, t3 = ba == 4 * bcg + 3 ? 1.f : 0.f;
            BC_STEP4(0, l0, -, t0, t1, t2, t3, t0, t1, t2, t3) BC_STEP4(1, l1, -, t0, t1, t2, t3, t0, t1, t2, t3) BC_STEP4(2, l2, -, t0, t1, t2, t3, t0, t1, t2, t3)
            BC_STEP(12, -l3.x, t0, t1, t2, t3, t0, t1, t2, t3) BC_STEP(13, -l3.y, t0, t1, t2, t3, t0, t1, t2, t3) BC_STEP(14, -l3.z, t0, t1, t2, t3, t0, t1, t2, t3)
            const f32x4 tv = (f32x4){t0, t1, t2, t3};
            *(LAS f32x4*)(Tf + (16 * w + ba) * AML + 16 * w + 4 * bcg) = tv;
        }
        __syncthreads();
        if (w < 2) {
            f32x4 acc = (f32x4){0.f, 0.f, 0.f, 0.f};
            blk_mm(AMf + (32 * w + 16) * AML + 32 * w, AML, Tf + (32 * w) * AML + 32 * w, AML, acc, ba, bcg);
            *(LAS f32x4*)(TMP + w * 256 + ba * 16 + 4 * bcg) = acc;
        }
        __syncthreads();
        if (w < 2) {
            f32x4 acc = (f32x4){0.f, 0.f, 0.f, 0.f};
            blk_mm(Tf + (32 * w + 16) * AML + 32 * w + 16, AML, TMP + w * 256, 16, acc, ba, bcg);
            *(LAS f32x4*)(Tf + (32 * w + 16 + ba) * AML + 32 * w + 4 * bcg) = -acc;
        }
        __syncthreads();
        if (w < 4) {
            const int yi = w >> 1, yj = w & 1; f32x4 acc = (f32x4){0.f, 0.f, 0.f, 0.f};
            if (yj == 0) blk_mm(AMf + (32 + 16 * yi) * AML + 0, AML, Tf + 0, AML, acc, ba, bcg);
            blk_mm(AMf + (32 + 16 * yi) * AML + 16, AML, Tf + 16 * AML + 16 * yj, AML, acc, ba, bcg);
            *(LAS f32x4*)(TMP + (2 + w) * 256 + ba * 16 + 4 * bcg) = acc;
        }
        __syncthreads();
        if (w < 4) {
            const int ti = w >> 1, tj = w & 1; f32x4 acc = (f32x4){0.f, 0.f, 0.f, 0.f};
            blk_mm(Tf + (32 + 16 * ti) * AML + 32, AML, TMP + (2 + tj) * 256, 16, acc, ba, bcg);
            if (ti == 1) blk_mm(Tf + 48 * AML + 48, AML, TMP + (4 + tj) * 256, 16, acc, ba, bcg);
            *(LAS f32x4*)(Tf + (32 + 16 * ti + ba) * AML + 16 * tj + 4 * bcg) = -acc;
        }
        __syncthreads();
        {
            const int c8 = tid & 7; const bool lower = (8 * c8) / 16 <= i / 16;
            const f32x4 t0 = *(const LAS f32x4*)(Tf + i * AML + 8 * c8), t1 = *(const LAS f32x4*)(Tf + i * AML + 8 * c8 + 4);
            v4u o = (v4u){pk2(t0.x, t0.y), pk2(t0.z, t0.w), pk2(t1.x, t1.y), pk2(t1.z, t1.w)};
            if (!lower) o = (v4u){0u, 0u, 0u, 0u};
            *(LAS v4u*)(lds + L_TB + (i * 72 + 8 * c8) * 2) = o;
        }
    }
    __syncthreads();
#pragma unroll
    for (int it8 = 0; it8 < 8; ++it8) { const int idx = w + 8 * it8;
        const int which = idx >> 5, tm = (idx >> 3) & 3, tn = idx & 7;
        f32x4 acc = (f32x4){0.f, 0.f, 0.f, 0.f};
#pragma unroll
        for (int ks = 0; ks < 2; ++ks) {
            const bf16x8 tf = *(const LAS bf16x8*)(lds + L_TB + ((16 * tm + fr) * 72 + 32 * ks + 8 * fq) * 2);
            const bf16x8 xf = *(const LAS bf16x8*)(lds + (which == 0 ? L_KTT : L_VTT) + ((16 * tn + fr) * 72 + 8 * ((4 * ks + fq) ^ tn)) * 2);
            acc = which == 0 ? MFMA16(xf, tf, acc) : MFMA16(tf, xf, acc);
        }
        const v2u o = (v2u){pk2(acc[0], acc[1]), pk2(acc[2], acc[3])};
        if (which == 0) *(LAS v2u*)(lds + L_WST + ((16 * tm + fr) * 136 + 16 * tn + 4 * fq) * 2) = o;
        else *(LAS v2u*)(lds + L_UST + ((16 * tn + fr) * 68 + 16 * tm + 4 * fq) * 2) = o;
    }
    __syncthreads();
    if (!VIRT) {
#pragma unroll
    for (int s = 0; s < 2; ++s) { const int q = tid + 512 * s;
        { const int row = q >> 4, c = q & 15; *(v4u*)((bf16*)(rec + R_W) + row * 128 + 8 * c) = *(const LAS v4u*)(lds + L_WST + (row * 136 + 8 * c) * 2); }
        { const int row = q >> 3, c = q & 7; const LAS v2u* p = (const LAS v2u*)(lds + L_UST + (row * 68 + 8 * c) * 2); const v2u lo = p[0], hi = p[1];
          *(v4u*)((bf16*)(rec + R_UBT) + row * 64 + 8 * c) = (v4u){lo.x, lo.y, hi.x, hi.y}; } }
    { const int row = tid >> 3, c = tid & 7; *(v4u*)((bf16*)(rec + R_QK) + row * 64 + 8 * c) = *(const LAS v4u*)(lds + L_QST + (row * 72 + 8 * c) * 2); }
#pragma unroll
    for (int s = 0; s < 2; ++s) { const int q = tid + 512 * s, row = q >> 3, c16 = q & 7;
        *(v4u*)((bf16*)(rec + R_KDT) + row * 64 + 8 * c16) = *(const LAS v4u*)(lds + L_KDS + (row * 72 + 8 * (c16 ^ ((row >> 4) & 7))) * 2); }
    if (tid == 0) ((float*)(a.ws + WS_CDEC))[(n * 8 + h) * NCH + j] = __expf(SC[128 + 63]);
    } else {
        float* sm = (float*)(a.ws + WS_SMETA) + (size_t)h * 128 * 128;
        const int d = 16 * w + fr;
        bf16x8 kf[2];
#pragma unroll
        for (int ks = 0; ks < 2; ++ks) kf[ks] = *(const LAS bf16x8*)(lds + L_KDS + (d * 72 + 8 * ((4 * ks + fq) ^ ((d >> 4) & 7))) * 2);
#pragma unroll
        for (int te = 0; te < 8; ++te) { f32x4 acc = (f32x4){0.f, 0.f, 0.f, 0.f};
#pragma unroll
            for (int ks = 0; ks < 2; ++ks) { const LAS v2u* p = (const LAS v2u*)(lds + L_UST + ((16 * te + fr) * 68 + 32 * ks + 8 * fq) * 2); const v2u lo = p[0], hi = p[1];
                acc = MFMA16(kf[ks], __builtin_bit_cast(bf16x8, (v4u){lo.x, lo.y, hi.x, hi.y}), acc); }
#pragma unroll
            for (int r = 0; r < 4; ++r) sm[(16 * w + 4 * fq + r) * 128 + 16 * te + fr] = acc[r]; }
    }
    __syncthreads();
    return nxt;
}
__device__ __forceinline__ int dn_pre_item(const Ctx& C, const Args& a, int it, int jbase, int nitems, int qid, unsigned char* sreg, PreLd& L) {
    int n, h, j, nh, jl; pre_item_of(it, jbase, n, h, j, nh, jl);
    unsigned char* rec = sreg + SR_DNI + ((size_t)nh * CH1 + jl) * DNI_REC;
    if (j == 0 && n == 0) { PreLd V; pre_issue(a, 0, h, -1, V); (void)pre_core<true>(C, a, 0, h, -1, rec, jbase, nitems, qid, V); }
    return pre_core<false>(C, a, n, h, j, rec, jbase, nitems, qid, L);
}
constexpr int L_ST = 0, L_UT = 4352, L_OST = 10240  , L_REC = 16384, REC_LDS = 59392;
constexpr int RL_W = 0, RL_QD = 16384, RL_KDT = 32768, RL_QK = 49152, RL_UB = 57344;
constexpr int SCAN_NLD = 9;
__device__ __forceinline__ unsigned scan_src(int q, int es) {
    if (q < 2048) { const int r = (q >> 4) & 63, s_ = q & 15, qd = q >> 10; return (qd ? R_QD : R_W) + r * 256 + ((s_ ^ (r & 15)) << 4); }
    else if (q < 3072) { const int p = q - 2048, r = p >> 3, s_ = p & 7; return R_KDT + r * 128 + ((s_ ^ (r & 7)) << 4); }
    else if (q < 3584) { const int p = q - 3072, r = p >> 3, s_ = p & 7; return R_QK + r * 128 + ((s_ ^ (r & 7)) << 4); }
    else { const int p = (q - 3584) & 127; return R_UBT + (16 * es) * 128 + p * 16; }
}
__device__ __forceinline__ void glds16(const void* gsrc, unsigned lds_dst) {
    unsigned keep;
    asm volatile("s_mov_b32 %0, m0\n\ts_mov_b32 m0, %2\n\ts_nop 0\n\tglobal_load_lds_dwordx4 %1, off\n\ts_mov_b32 m0, %0" : "=&s"(keep) : "v"(gsrc), "s"(lds_dst) : "memory");
}
__device__ __forceinline__ void dn_scan_item(const Ctx& C, const Args& a, int nh, int es, int jbase, int nc, bool first_half) {
    int tid = ((int)threadIdx.x); asm volatile("" : "+v"(tid)); const int lane = tid & 63, w = C.wave, fr = lane & 15, fq = lane >> 4;
    LAS unsigned char* lds = C.lds;
    const int n = nh >> 3, h = nh & 7;
    const unsigned char* dni = (const unsigned char*)(a.out + O_SCONV) + SR_DNI + (size_t)nh * CH1 * DNI_REC;
    const float* cdec = (const float*)(a.ws + WS_CDEC) + nh * NCH + jbase;
    float* ssave = (float*)(a.ws + WS_SSAVE) + (size_t)nh * 128 * 128;
    bf16* ORAW = (bf16*)(a.ws + WS_QKV);
    if (w == 7) {
        __syncthreads(); __syncthreads();
        bf16* orow = ORAW + (size_t)(n * TP) * 3072 + h * 128 + 16 * es;
        for (int jl = 0; jl <= nc; ++jl) {
            if (jl > 0) { const int t = 64 * (jbase + jl - 1) + 16 + lane; const LAS v4u* src = (const LAS v4u*)(lds + L_OST + ((jl - 1) & 1) * 2048 + lane * 32);
                const v4u o0 = src[0], o1 = src[1];
                if (t >= 0) { v4u* dst = (v4u*)(orow + (size_t)t * 3072); STNT(o0, dst); STNT(o1, dst + 1); } }
            if (jl < nc) { __syncthreads(); __syncthreads(); }
        }
        return;
    }
    unsigned goff[SCAN_NLD];
#pragma unroll
    for (int k = 0; k < SCAN_NLD; ++k) { const int q = tid + 448 * k; goff[k] = scan_src(q < 3712 ? q : 3711, es); }
    const bool last_ok = tid + 448 * (SCAN_NLD - 1) < 3712;
    const unsigned img0 = (unsigned)(size_t)(lds + L_REC) + (unsigned)(64 * w) * 16u;
#define SCAN_DMA(J) do { const unsigned char* rp_ = dni + (size_t)(J) * DNI_REC; const unsigned ib_ = img0 + ((J) & 1) * REC_LDS; \
        _Pragma("unroll") for (int k = 0; k < SCAN_NLD - 1; ++k) glds16(rp_ + goff[k], ib_ + 448 * 16 * k); \
        if (last_ok) glds16(rp_ + goff[SCAN_NLD - 1], ib_ + 448 * 16 * (SCAN_NLD - 1)); } while (0)
#define SCAN_DMA_WAIT() asm volatile("s_waitcnt vmcnt(0)" ::: "memory")
    const int r0 = 16 * w + 4 * fq, r1 = 112 + 4 * fq;
    f32x4 S = (f32x4){0.f, 0.f, 0.f, 0.f}, S2 = (f32x4){0.f, 0.f, 0.f, 0.f};
    { const float* sin = first_half ? (const float*)(a.ws + WS_SMETA) + (size_t)h * 128 * 128 : ssave;
#pragma unroll
        for (int r = 0; r < 4; ++r) { S[r] = sin[(r0 + r) * 128 + 16 * es + fr]; if (w == 4) S2[r] = sin[(r1 + r) * 128 + 16 * es + fr]; }
    }
    LAS float* CDL = (LAS float*)(lds + L_OST + 4096);
    if (tid < nc) CDL[tid] = cdec[tid];
    asm volatile("s_waitcnt vmcnt(0)" ::: "memory");
    __syncthreads();
    *(LAS v2u*)(lds + L_ST + (fr * 136 + r0) * 2) = (v2u){pk2(S[0], S[1]), pk2(S[2], S[3])};
    if (w == 4) *(LAS v2u*)(lds + L_ST + (fr * 136 + r1) * 2) = (v2u){pk2(S2[0], S2[1]), pk2(S2[2], S2[3])};
    SCAN_DMA(0);
    SCAN_DMA_WAIT();
    __syncthreads();
    for (int jl = 0; jl < nc; ++jl) {
        const LAS unsigned char* im = lds + L_REC + (jl & 1) * REC_LDS;
        const float cd = CDL[jl];
        if (w < 4) __builtin_amdgcn_s_setprio(2);
        if (jl + 1 < nc) SCAN_DMA(jl + 1);
        bf16x8 Sf[4];
        if (w < 4) {
            const int rr = 16 * w + fr;
#pragma unroll
            for (int ks = 0; ks < 4; ++ks) Sf[ks] = *(const LAS bf16x8*)(lds + L_ST + (fr * 136 + 32 * ks + 8 * fq) * 2);
            f32x4 X = (f32x4){0.f, 0.f, 0.f, 0.f}, Xb = (f32x4){0.f, 0.f, 0.f, 0.f};
#pragma unroll
            for (int ks = 0; ks < 4; ks += 2) { X = MFMA16(*(const LAS bf16x8*)(im + RL_W + rr * 256 + (((4 * ks + fq) ^ (rr & 15)) << 4)), Sf[ks], X);
                Xb = MFMA16(*(const LAS bf16x8*)(im + RL_W + rr * 256 + (((4 * ks + 4 + fq) ^ (rr & 15)) << 4)), Sf[ks + 1], Xb); }
            X += Xb;
            const v2u ub = *(const LAS v2u*)(im + RL_UB + fr * 128 + (16 * w + 4 * fq) * 2);
            const float u0 = bflo(ub.x) - X[0], u1 = bfhi(ub.x) - X[1], u2 = bflo(ub.y) - X[2], u3 = bfhi(ub.y) - X[3];
            *(LAS v2u*)(lds + L_UT + (fr * 72 + 16 * w + 4 * fq) * 2) = (v2u){pk2(u0, u1), pk2(u2, u3)};
            __builtin_amdgcn_s_setprio(0);
        }
        __syncthreads();
        bf16x8 Uf[2], Kf[2], K2f[2], Qf[4], QKf[2];
        Uf[0] = *(const LAS bf16x8*)(lds + L_UT + (fr * 72 + 8 * fq) * 2); Uf[1] = *(const LAS bf16x8*)(lds + L_UT + (fr * 72 + 32 + 8 * fq) * 2);
        { const int rk = 16 * w + fr;
            Kf[0] = *(const LAS bf16x8*)(im + RL_KDT + rk * 128 + ((fq ^ (rk & 7)) << 4)); Kf[1] = *(const LAS bf16x8*)(im + RL_KDT + rk * 128 + (((4 + fq) ^ (rk & 7)) << 4)); }
        if (w == 4) { const int rk = 112 + fr;
            K2f[0] = *(const LAS bf16x8*)(im + RL_KDT + rk * 128 + ((fq ^ (rk & 7)) << 4)); K2f[1] = *(const LAS bf16x8*)(im + RL_KDT + rk * 128 + (((4 + fq) ^ (rk & 7)) << 4)); }
        if (w < 4) { const int rr = 16 * w + fr;
#pragma unroll
            for (int q4 = 0; q4 < 4; ++q4) Qf[q4] = *(const LAS bf16x8*)(im + RL_QD + rr * 256 + (((4 * q4 + fq) ^ (rr & 15)) << 4));
            QKf[0] = *(const LAS bf16x8*)(im + RL_QK + rr * 128 + ((fq ^ (rr & 7)) << 4)); QKf[1] = *(const LAS bf16x8*)(im + RL_QK + rr * 128 + (((4 + fq) ^ (rr & 7)) << 4)); }
        S = S * cd; if (w == 4) S2 = S2 * cd;
        asm volatile("s_waitcnt lgkmcnt(0)" ::: "memory");
        __builtin_amdgcn_sched_barrier(0);
        S = MFMA16(Kf[0], Uf[0], S);
        if (w == 4) S2 = MFMA16(K2f[0], Uf[0], S2);
        S = MFMA16(Kf[1], Uf[1], S);
        if (w == 4) S2 = MFMA16(K2f[1], Uf[1], S2);
        *(LAS v2u*)(lds + L_ST + (fr * 136 + r0) * 2) = (v2u){pk2(S[0], S[1]), pk2(S[2], S[3])};
        if (w == 4) *(LAS v2u*)(lds + L_ST + (fr * 136 + r1) * 2) = (v2u){pk2(S2[0], S2[1]), pk2(S2[2], S2[3])};
        if (w < 4) {
            f32x4 O = (f32x4){0.f, 0.f, 0.f, 0.f}, Ob = (f32x4){0.f, 0.f, 0.f, 0.f}, Oc = (f32x4){0.f, 0.f, 0.f, 0.f};
            O = MFMA16(Qf[0], Sf[0], O); Ob = MFMA16(Qf[1], Sf[1], Ob); Oc = MFMA16(QKf[0], Uf[0], Oc);
            O = MFMA16(Qf[2], Sf[2], O); Ob = MFMA16(Qf[3], Sf[3], Ob); Oc = MFMA16(QKf[1], Uf[1], Oc);
            O += Ob + Oc;
            LAS bf16* ost = (LAS bf16*)(lds + L_OST + (jl & 1) * 2048) + (16 * w + 4 * fq) * 16 + fr;
#pragma unroll
            for (int r = 0; r < 4; ++r) ost[r * 16] = (bf16)f2bf(O[r]);
        }
        SCAN_DMA_WAIT();
        __syncthreads();
    }
#undef SCAN_DMA
#undef SCAN_DMA_WAIT
    float* ps = first_half ? ssave : a.out + O_PSSM + (size_t)nh * 128 * 128;
#pragma unroll
    for (int r = 0; r < 4; ++r) { ps[(r0 + r) * 128 + 16 * es + fr] = S[r]; if (w == 4) ps[(r1 + r) * 128 + 16 * es + fr] = S2[r]; }
}
constexpr int SDN_LDS = 35840;
__device__ __forceinline__ void sdn_batch(const Ctx& C, const Args& a, int batch) {
    int tid = (int)threadIdx.x; asm volatile("" : "+v"(tid)); const int lane = tid & 63, w = C.wave;
    const int sub = tid >> 8, t8 = tid & 255, item = 2 * batch + sub, n = item >> 3, h = item & 7;
    const int e = 32 * (w & 3) + (lane & 31), dg = lane >> 5;
    LAS unsigned char* lds = C.lds + sub * SDN_LDS;
    LAS float* RAW = (LAS float*)lds; LAS float* XS = (LAS float*)(lds + 16896); LAS float* SCB = (LAS float*)(lds + 16896 + 12288); LAS float* CWS = (LAS float*)(lds + 29312);
    const bf16* QKV = (const bf16*)(a.ws + WS_QKV); const float* BA = (const float*)(a.ws + WS_BA);
    const int row0 = PROWS + n * ST;
    f32x4 hx[3]; v4u nx[3]; f32x4 cwx[2];
#pragma unroll
    for (int k = 0; k < 3; ++k) {
        const int p = t8 + 256 * k;
        if (p < 288) { const int rr = p / 96, c = (p - rr * 96) * 4, col = (c >> 7) * 1024 + h * 128 + (c & 127); hx[k] = *(const f32x4*)(a.in[2] + (size_t)(n * 3 + rr) * 3072 + col); }
        else if (p < 672) { const int q = p - 288, rn = q / 48, c = (q - rn * 48) * 8, col = (c >> 7) * 1024 + h * 128 + (c & 127); nx[k] = *(const v4u*)(QKV + (size_t)(row0 + rn) * 3072 + col); }
    }
#pragma unroll
    for (int k = 0; k < 2; ++k) { const int q = t8 + 256 * k; if (q < 384) { const int tap = q / 96, c = (q - tap * 96) * 4;
        cwx[k] = *(const f32x4*)(a.in[17] + tap * 3072 + (c >> 7) * 1024 + h * 128 + (c & 127)); } }
    float bav0 = 0.f, bav1 = 0.f;
    if (t8 < 8) { const float* ba = BA + (size_t)(row0 + t8) * 16; bav0 = ba[h]; bav1 = ba[8 + h]; }
    const float* sp = a.in[3] + (size_t)(n * 8 + h) * 16384 + (size_t)(64 * dg) * 128 + e;
    float S[64];
#pragma unroll
    for (int g = 0; g < 8; ++g) { const float* pg = sp + g * 1024; asm volatile("" : "+v"(pg));
#pragma unroll
        for (int j = 0; j < 8; ++j) S[8 * g + j] = LDNT(pg + j * 128); }
#pragma unroll
    for (int k = 0; k < 3; ++k) {
        const int p = t8 + 256 * k;
        if (p < 288) { const int rr = p / 96, c = (p - rr * 96) * 4; *(LAS f32x4*)(RAW + rr * 384 + c) = hx[k]; }
        else if (p < 672) { const int q = p - 288, rn = q / 48, c = (q - rn * 48) * 8, col = (c >> 7) * 1024 + h * 128 + (c & 127);
            const v4u wv = nx[k];
            const f32x4 x0 = (f32x4){bflo(wv.x), bfhi(wv.x), bflo(wv.y), bfhi(wv.y)}, x1 = (f32x4){bflo(wv.z), bfhi(wv.z), bflo(wv.w), bfhi(wv.w)};
            *(LAS f32x4*)(RAW + (3 + rn) * 384 + c) = x0; *(LAS f32x4*)(RAW + (3 + rn) * 384 + c + 4) = x1;
            if (rn >= 5) { float* d = a.out + O_SCONV + (size_t)(n * 3 + (rn - 5)) * 3072 + col; *(f32x4*)d = x0; *(f32x4*)(d + 4) = x1; } }
    }
#pragma unroll
    for (int k = 0; k < 2; ++k) { const int q = t8 + 256 * k; if (q < 384) { const int tap = q / 96, c = (q - tap * 96) * 4; *(LAS f32x4*)(CWS + tap * 384 + c) = cwx[k]; } }
    if (t8 < 8) { SCB[t8] = sigmoidf_(bav0);
        const float x = bav1 + a.in[19][h]; const float spv = x > 20.f ? x : log1pf(__expf(x)); SCB[8 + t8] = __expf(-__expf(a.in[18][h]) * spv); }
    __syncthreads();
#pragma unroll
    for (int k = 0; k < 12; ++k) {
        const int idx = t8 + 256 * k, t = idx / 384, c = idx - t * 384;
        float acc = 0.f;
#pragma unroll
        for (int tap = 0; tap < 4; ++tap) acc += CWS[tap * 384 + c] * RAW[(t + tap) * 384 + c];
        XS[((c >> 7) * 8 + t) * 128 + (c & 127)] = siluf_(acc);
    }
    __syncthreads();
#pragma unroll
    for (int rr = 0; rr < 4; ++rr) { const int row = 4 * (w & 3) + rr; const float x0 = XS[row * 128 + lane], x1 = XS[row * 128 + 64 + lane];
        const float rs = rsqrtf(wave_sum(x0 * x0 + x1 * x1) + L2_EPS) * (row < 8 ? 0.08838834764831845f : 1.0f);
        XS[row * 128 + lane] = x0 * rs; XS[row * 128 + 64 + lane] = x1 * rs; }
    __syncthreads();
    bf16* OS = (bf16*)(a.ws + WS_OS) + (size_t)(n * ST) * 1024 + h * 128 + e;
#pragma unroll 1
    for (int t = 0; t < ST; ++t) {
        const float dec = SCB[8 + t], beta = SCB[t];
        const LAS float* qp = XS + t * 128 + 64 * dg; const LAS float* kp = XS + (8 + t) * 128 + 64 * dg;
        float ks0 = 0.f, ks1 = 0.f;
#pragma unroll
        for (int d = 0; d < 64; d += 4) { const f32x4 kv = *(const LAS f32x4*)(kp + d);
            S[d] *= dec; S[d + 1] *= dec; S[d + 2] *= dec; S[d + 3] *= dec;
            ks0 += kv.x * S[d]; ks1 += kv.y * S[d + 1]; ks0 += kv.z * S[d + 2]; ks1 += kv.w * S[d + 3]; }
        float ks = sum_x32(ks0 + ks1);
        const float u = beta * (XS[(16 + t) * 128 + e] - ks);
        float o0 = 0.f, o1 = 0.f;
#pragma unroll
        for (int d = 0; d < 64; d += 4) { const f32x4 kv = *(const LAS f32x4*)(kp + d), qv = *(const LAS f32x4*)(qp + d);
            S[d] += kv.x * u; S[d + 1] += kv.y * u; S[d + 2] += kv.z * u; S[d + 3] += kv.w * u;
            o0 += qv.x * S[d]; o1 += qv.y * S[d + 1]; o0 += qv.z * S[d + 2]; o1 += qv.w * S[d + 3]; }
        float o = sum_x32(o0 + o1);
        if (dg == 0) __hip_atomic_store((GAS unsigned short*)(OS + (size_t)t * 1024), (unsigned short)f2bf(o), RLX_AGENT);
    }
    asm volatile("s_waitcnt vmcnt(0)" ::: "memory");
    __syncthreads();
    if (tid == 0) (void)__hip_atomic_fetch_add((unsigned*)(C.ctl + CW_SDN + 16 * n), 1u, RLX_AGENT);
    float* so = a.out + O_SSSM + (size_t)(n * 8 + h) * 16384 + (size_t)(64 * dg) * 128 + e;
#pragma unroll
    for (int g = 0; g < 8; ++g) { float* pg = so + g * 1024; asm volatile("" : "+v"(pg));
#pragma unroll
        for (int j = 0; j < 8; ++j) STNT(S[8 * g + j], pg + j * 128); }
}
__device__ __forceinline__ void state_copies(const Ctx& C, const Args& a, int part) {
    const bf16* SKV = (const bf16*)(a.ws + WS_SKV);
    int tid = (int)threadIdx.x; asm volatile("" : "+v"(tid));
    { const int n = part >> 2, isv = (part >> 1) & 1, half = part & 1;
      v4u nw = (v4u){0u, 0u, 0u, 0u}; const int nrow = half * 4 + (tid >> 5), nc = (tid & 31) * 8;
      if (tid < 128) nw = *(const v4u*)(SKV + (size_t)(PROWS + n * ST + nrow) * 512 + isv * 256 + nc);
      const int pv = part * 72 + (tid < 72 ? tid : 0), c8 = pv & 63, rw = (pv >> 6) % 144, pn = pv / (144 * 64);
      const int pt = rw < 16 ? rw : TP - 128 + (rw - 16);
      v4u pw = (v4u){0u, 0u, 0u, 0u};
      if (tid < 72) pw = *(const v4u*)(SKV + (size_t)(pn * TP + pt) * 512 + 8 * c8);
      if (tid < 128) { float* d = a.out + (isv ? O_SWV : O_SWK) + (size_t)(n * 128 + 120 + nrow) * 256 + nc;
          STNT((f32x4){bflo(nw.x), bfhi(nw.x), bflo(nw.y), bfhi(nw.y)}, (f32x4*)d); STNT((f32x4){bflo(nw.z), bfhi(nw.z), bflo(nw.w), bfhi(nw.w)}, (f32x4*)(d + 4)); }
      if (tid < 72) { const int pisv = c8 >> 5, cc = (c8 & 31) * 8;
          float* d = rw < 16 ? a.out + (pisv ? O_PMV : O_PMK) + (size_t)(pn * 16 + rw) * 256 + cc : a.out + (pisv ? O_PWV : O_PWK) + (size_t)(pn * 128 + (rw - 16)) * 256 + cc;
          STNT((f32x4){bflo(pw.x), bfhi(pw.x), bflo(pw.y), bfhi(pw.y)}, (f32x4*)d); STNT((f32x4){bflo(pw.z), bfhi(pw.z), bflo(pw.w), bfhi(pw.w)}, (f32x4*)(d + 4)); }
    }
}
constexpr int L_KL = 0, L_STG = 117504  , L_VT = 56576, VT_LD = 136  , KL_LD = 136;
constexpr float LOG2E = 1.44269504089f;

template <bool SAMPLE> __device__ __forceinline__ void swa_item(const Ctx& C, const Args& a, int n, int kvh, int jb) {
    constexpr int QT = SAMPLE ? 1 : 2, NKT = SAMPLE ? 10 : 13, NKS = SAMPLE ? 5 : 7, NKEYS = SAMPLE ? 160 : 224;
    int tid = ((int)threadIdx.x); asm volatile("" : "+v"(tid)); const int lane = tid & 63, w = C.wave, fr = lane & 15, fq = lane >> 4;
    LAS unsigned char* lds = C.lds;
    const bf16* SKV = (const bf16*)(a.ws + WS_SKV); const bf16* SQ = (const bf16*)(a.ws + WS_SQ);
    const int q_start = 64 * jb + 16;
    constexpr int NCHK = NKEYS * 16 / 512;
    v4u kws[NCHK], vws[NCHK];
    f32x4 kf0[NCHK], kf1[NCHK], vf0[NCHK], vf1[NCHK];
    if (!SAMPLE) {
#pragma unroll
        for (int s = 0; s < NCHK; ++s) { const int q = tid + 512 * s, key = q >> 4, c8 = q & 15;
            int pos = key < 16 ? key : q_start - 128 + (key - 16); const bool ok = key < 208 && pos >= 0; pos = ok ? pos : 0;
            const bf16* p = SKV + (size_t)(n * TP + pos) * 512 + kvh * 128 + 8 * c8; kws[s] = *(const v4u*)p; vws[s] = *(const v4u*)(p + 256);
            if (!ok) { kws[s] = (v4u){0u, 0u, 0u, 0u}; vws[s] = (v4u){0u, 0u, 0u, 0u}; } }
    } else {
#pragma unroll
        for (int s = 0; s < NCHK; ++s) { const int q = tid + 512 * s, key = q >> 4, c8 = q & 15;
            if (key < 144) {
                const size_t o = key < 16 ? ((size_t)(n * 16 + key) * 2 + kvh) * 128 + 8 * c8 : ((size_t)(n * 128 + (key - 16)) * 2 + kvh) * 128 + 8 * c8;
                const float* kp = (key < 16 ? a.in[4] : a.in[6]) + o; const float* vp = (key < 16 ? a.in[5] : a.in[7]) + o;
                const f32x4 k0 = LDNT((const f32x4*)kp), k1 = LDNT((const f32x4*)(kp + 4)), v0 = LDNT((const f32x4*)vp), v1 = LDNT((const f32x4*)(vp + 4));
                kws[s] = (v4u){pk2(k0.x, k0.y), pk2(k0.z, k0.w), pk2(k1.x, k1.y), pk2(k1.z, k1.w)}; vws[s] = (v4u){pk2(v0.x, v0.y), pk2(v0.z, v0.w), pk2(v1.x, v1.y), pk2(v1.z, v1.w)};
                kf0[s] = k0; kf1[s] = k1; vf0[s] = v0; vf1[s] = v1;
            } else { const int kn = key < 152 ? key - 144 : 0;
                const bf16* p = SKV + (size_t)(PROWS + n * ST + kn) * 512 + kvh * 128 + 8 * c8; kws[s] = *(const v4u*)p; vws[s] = *(const v4u*)(p + 256);
                if (key >= 152) { kws[s] = (v4u){0u, 0u, 0u, 0u}; vws[s] = (v4u){0u, 0u, 0u, 0u}; } } }
    }
    bf16x8 Qall[QT][4];
#pragma unroll
    for (int qt = 0; qt < QT; ++qt) { int hq0, rowq0;
        if (!SAMPLE) { hq0 = kvh * 4 + (w >> 1); const int pq = q_start + 32 * (w & 1) + 16 * qt + fr; rowq0 = n * TP + (pq >= 0 ? pq : 0); }
        else { hq0 = kvh * 4 + 2 * (w & 1) + (fr >> 3); rowq0 = PROWS + n * ST + (fr & 7); }
#pragma unroll
        for (int ks = 0; ks < 4; ++ks) Qall[qt][ks] = LDNT((const bf16x8*)(SQ + ((unsigned)rowq0 * 1024u + hq0 * 128 + 32 * ks + 8 * fq))); }
#pragma unroll
    for (int s = 0; s < NCHK; ++s) { const int q = tid + 512 * s, key = q >> 4, c8 = q & 15; const v4u kw = kws[s], vw = vws[s];
        if (key < 208) *(LAS v4u*)(lds + L_KL + (key * KL_LD + 8 * c8) * 2) = kw;
        *(LAS v4u*)(lds + L_VT + (key * VT_LD + 8 * c8) * 2) = vw;
    }
    if (SAMPLE) {
#pragma unroll
        for (int s = 0; s < NCHK; ++s) { const int q = tid + 512 * s, key = q >> 4, c8 = q & 15;
            if (key >= 24 && key < 144) { const size_t o = ((size_t)(n * 128 + (key - 24)) * 2 + kvh) * 128 + 8 * c8;
                float* dk = a.out + O_SWK + o; float* dv = a.out + O_SWV + o;
                STNT(kf0[s], (f32x4*)dk); STNT(kf1[s], (f32x4*)(dk + 4)); STNT(vf0[s], (f32x4*)dv); STNT(vf1[s], (f32x4*)(dv + 4)); } }
    }
    __syncthreads();
    if (SAMPLE && w >= 2) return;
#pragma unroll 1
    for (int qt = 0; qt < QT; ++qt) {
    int hq, posq, rowq; bool okq; int zo = 0; asm volatile("" : "+v"(zo));
    if (!SAMPLE) { hq = kvh * 4 + (w >> 1); posq = q_start + 32 * (w & 1) + 16 * qt + fr; okq = posq >= 0; rowq = n * TP + (okq ? posq : 0); }
    else { hq = kvh * 4 + 2 * w + (fr >> 3); posq = fr & 7; okq = true; rowq = PROWS + n * ST + (fr & 7); }
    bf16x8 Qf[4];
#pragma unroll
    for (int ks = 0; ks < 4; ++ks) Qf[ks] = (QT > 1 && qt) ? Qall[QT - 1][ks] : Qall[0][ks];
    f32x4 sc[NKT];
#pragma unroll
    for (int kt = 0; kt < NKT; ++kt) {
        f32x4 acc = (f32x4){0.f, 0.f, 0.f, 0.f}, acb = (f32x4){0.f, 0.f, 0.f, 0.f};
#pragma unroll
        for (int ks = 0; ks < 4; ks += 2) { acc = MFMA16(*(const LAS bf16x8*)(lds + zo + L_KL + ((16 * kt + fr) * KL_LD + 32 * ks + 8 * fq) * 2), Qf[ks], acc);
            acb = MFMA16(*(const LAS bf16x8*)(lds + zo + L_KL + ((16 * kt + fr) * KL_LD + 32 * ks + 32 + 8 * fq) * 2), Qf[ks + 1], acb); }
        sc[kt] = acc + acb; if (kt & 1) __builtin_amdgcn_sched_barrier(0);
    }
    unsigned P[NKT][2];
    {
        const float slope2 = exp2f(-(float)(hq + 1)) * LOG2E, sink2 = a.in[21][hq + zo] * LOG2E, scale2 = 0.08838834764831845f * LOG2E;
        float mx = sink2;
        int bd, md0, kmin;
        if (!SAMPLE) { bd = posq - q_start + 144 - 4 * fq; md0 = posq - 4 * fq; kmin = 160 - q_start - 4 * fq; }
        else { bd = 144 + posq - 4 * fq; md0 = 0; kmin = -1000; }
#pragma unroll
        for (int kt = 0; kt < NKT; ++kt)
#pragma unroll
            for (int r = 0; r < 4; ++r) {
                int dist; bool vis;
                if (kt == 0) { if (!SAMPLE) { dist = md0 - r; vis = dist >= 0; dist = dist < 128 ? dist : 128; } else { dist = 128; vis = true; } }
                else if (!SAMPLE) { dist = bd - (16 * kt + r); vis = (unsigned)dist <= 128u && (16 * kt + r) >= kmin; }
                else if (kt < 9) { dist = bd - (16 * kt + r); vis = dist <= 128; }
                else { dist = posq - (16 * kt + r - 144) - 4 * fq; vis = dist >= 0 && (16 * kt + r + 4 * fq) < 152; }
                const float l2 = vis ? sc[kt][r] * scale2 - slope2 * (float)dist : -INFINITY;
                sc[kt][r] = l2; mx = fmaxf(mx, l2);
            }
        mx = max_x32(max_x16(mx));
        float sum = 0.f;
#pragma unroll
        for (int kt = 0; kt < NKT; ++kt)
#pragma unroll
            for (int r = 0; r < 4; ++r) { const float p = exp2f(sc[kt][r] - mx); sc[kt][r] = p; sum += p; }
        sum = sum_x32(sum_x16(sum));
        const float inv = 1.0f / (sum + exp2f(sink2 - mx));
#pragma unroll
        for (int kt = 0; kt < NKT; ++kt) { P[kt][0] = pk2(sc[kt][0] * inv, sc[kt][1] * inv); P[kt][1] = pk2(sc[kt][2] * inv, sc[kt][3] * inv); }
    }
    f32x4 O[8];
#pragma unroll
    for (int dt = 0; dt < 8; ++dt) O[dt] = (f32x4){0.f, 0.f, 0.f, 0.f};
#pragma unroll
    for (int s = 0; s < NKS; ++s) {
        v4u pw; pw.x = P[2 * s][0]; pw.y = P[2 * s][1];
        if (2 * s + 1 < NKT) { pw.z = P[2 * s + 1][0]; pw.w = P[2 * s + 1][1]; } else { pw.z = 0u; pw.w = 0u; }
        const bf16x8 Pf = __builtin_bit_cast(bf16x8, pw);
#pragma unroll
        for (int dt = 0; dt < 8; ++dt) {
            const LAS unsigned char* vp = lds + zo + L_VT + ((32 * s + 4 * fq + (fr >> 2)) * VT_LD + 16 * dt + 4 * (fr & 3)) * 2;
            typedef short s16x4 __attribute__((ext_vector_type(4)));
            const s16x4 lo = __builtin_amdgcn_ds_read_tr16_b64_v4i16((LAS s16x4*)vp), hi = __builtin_amdgcn_ds_read_tr16_b64_v4i16((LAS s16x4*)(vp + 16 * VT_LD * 2));
            const bf16x8 Vf = (bf16x8){lo[0], lo[1], lo[2], lo[3], hi[0], hi[1], hi[2], hi[3]};
            O[dt] = MFMA16(Vf, Pf, O[dt]);
        }
    }
    {
        LAS unsigned char* stg = lds + L_STG + w * 4352;
#pragma unroll
        for (int dt = 0; dt < 8; ++dt) *(LAS v2u*)(stg + (fr * 136 + 16 * dt + 4 * fq) * 2) = (v2u){pk2(O[dt][0], O[dt][1]), pk2(O[dt][2], O[dt][3])};
        asm volatile("s_waitcnt lgkmcnt(0)" ::: "memory");
        const bf16* ORAW = SAMPLE ? (const bf16*)(a.ws + WS_OS) : (const bf16*)(a.ws + WS_QKV); bf16* GD = (bf16*)(a.ws + WS_GD); const bf16* GS = (const bf16*)(a.ws + WS_GS);
        const int rr = lane >> 4, ch = lane & 15;
        const f32x4 nw0 = *(const f32x4*)(a.in[20] + zo + 8 * ch), nw1 = *(const f32x4*)(a.in[20] + zo + 8 * ch + 4);
        v4u owA[4], gdA[4], gsA[4]; unsigned c1A[4]; bool okA[4];
#pragma unroll
        for (int g = 0; g < 4; ++g) {
            const int qi = 4 * g + rr; int hq2, row2; bool ok2;
            if (!SAMPLE) { hq2 = kvh * 4 + (w >> 1); const int p2 = q_start + 32 * (w & 1) + 16 * qt + qi; ok2 = p2 >= 0; row2 = n * TP + (ok2 ? p2 : 0); }
            else { hq2 = kvh * 4 + 2 * w + (qi >> 3); ok2 = true; row2 = PROWS + n * ST + (qi & 7); }
            const unsigned c1 = (unsigned)row2 * 1024u + hq2 * 128 + 8 * ch, c3 = SAMPLE ? (unsigned)(row2 - PROWS) * 1024u + hq2 * 128 + 8 * ch : (unsigned)row2 * 3072u + hq2 * 128 + 8 * ch;
            owA[g] = LDNT((const v4u*)(ORAW + c3)); gdA[g] = LDNT((const v4u*)(GD + c1)); gsA[g] = LDNT((const v4u*)(GS + c1)); c1A[g] = c1; okA[g] = ok2;
        }
#pragma unroll
        for (int g = 0; g < 4; ++g) {
            const int qi = 4 * g + rr; const v4u ow = owA[g], gdw = gdA[g], gsw = gsA[g];
            const v4u sw = *(const LAS v4u*)(stg + (qi * 136 + 8 * ch) * 2);
            float od[8] = {bflo(ow.x), bfhi(ow.x), bflo(ow.y), bfhi(ow.y), bflo(ow.z), bfhi(ow.z), bflo(ow.w), bfhi(ow.w)};
            float ss = 0.f;
#pragma unroll
            for (int i = 0; i < 8; ++i) ss += od[i] * od[i];
            ss = row_sum16(ss);
            const float rstd = rsqrtf(ss * (1.f / 128.f) + RMS_EPS);
            const float gd[8] = {bflo(gdw.x), bfhi(gdw.x), bflo(gdw.y), bfhi(gdw.y), bflo(gdw.z), bfhi(gdw.z), bflo(gdw.w), bfhi(gdw.w)};
            const float gs[8] = {bflo(gsw.x), bfhi(gsw.x), bflo(gsw.y), bfhi(gsw.y), bflo(gsw.z), bfhi(gsw.z), bflo(gsw.w), bfhi(gsw.w)};
            const float os[8] = {bflo(sw.x), bfhi(sw.x), bflo(sw.y), bfhi(sw.y), bflo(sw.z), bfhi(sw.z), bflo(sw.w), bfhi(sw.w)};
            const float nw[8] = {nw0.x, nw0.y, nw0.z, nw0.w, nw1.x, nw1.y, nw1.z, nw1.w};
            float y[8];
#pragma unroll
            for (int i = 0; i < 8; ++i) y[i] = gd[i] * (od[i] * rstd * nw[i]) + gs[i] * os[i];
            if (okA[g]) *(v4u*)(GD + c1A[g]) = (v4u){pk2(y[0], y[1]), pk2(y[2], y[3]), pk2(y[4], y[5]), pk2(y[6], y[7])};
        }
    }
    }
}
__global__ void __launch_bounds__(NWAVES * 64, 2) hyb_fwd(Args args) {
    extern __shared__ __attribute__((aligned(16))) unsigned char lds[];
    Ctx C;
    C.lds = (LAS unsigned char*)lds; C.MISC = (volatile LAS unsigned*)(C.lds + MISC_OFF);
    C.wave = __builtin_amdgcn_readfirstlane((int)threadIdx.x >> 6);
    C.G = gridDim.x; { const int bx = blockIdx.x; C.vcu = (C.G % 8 == 0) ? (bx % 8) * (C.G / 8) + bx / 8 : bx; }
    unsigned char* ws = args.ws; C.ctl = (gu32*)(ws + WS_CTL);
    for (int u = ((int)threadIdx.x); u < (LDS_BYTES - LDSCTL_OFF) / 4; u += NWAVES * 64) ((LAS unsigned*)(C.lds + LDSCTL_OFF))[u] = 0u;
    __syncthreads();
    XcdBarrier bar; bar.bar = (unsigned*)(C.ctl + CW_BAR); bar.x = 0; bar.st = nullptr;
    if (MK_N_LAUNCHES == 1) bar = xcd_barrier_post((unsigned*)(C.ctl + CW_BAR), C.MISC + 8);
    const int lo = args.ph_lo, hi = args.ph_hi;
#define IN(k) (lo <= (k) && (k) < hi)
#define SEAM(k) do { if (IN(k) && IN((k) + 1)) xcd_barrier(bar); } while (0)
    unsigned char* sreg = (unsigned char*)(args.out + O_SCONV);
    bf16* XN1 = (bf16*)(sreg + SR_XN); bf16* W3 = (bf16*)(sreg + SR_W3); bf16* WGU1 = (bf16*)(sreg + SR_WGU1); bf16* WD1 = (bf16*)(sreg + SR_WD1);
    bf16* HID = (bf16*)(ws + WS_HID); bf16* Fb = (bf16*)(ws + WS_F); bf16* FB2 = (bf16*)(ws + WS_FB);
    pg8::SplitK SKd; SKd.init(MP, D, FF, C.G, C.vcu); pg8::SplitK SKo; SKo.init(MP, D, D, C.G, C.vcu); bf16* XN2 = (bf16*)(ws + WS_XN2); bf16* WGU2 = (bf16*)(ws + WS_WGU2); bf16* WD2 = (bf16*)(ws + WS_WD2);
    bf16* WO = (bf16*)(ws + WS_WO);

    static constexpr int REPS[NPHASE] = PROBE_REPS;
#define PHASE(k, ...) do { if (IN(k)) { _Pragma("unroll 1") for (int rp = 0; rp < REPS[k]; ++rp) { if (rp) xcd_barrier(bar); __VA_ARGS__ } } SEAM(k); } while (0)
    PHASE(0,
        { const TrJob jobs[5] = {{args.in[11], WGU1, D, FF, 1}, {args.in[12], WGU1, D, FF, 2}, {args.in[13], WD1, FF, D, 0}, {args.in[16], W3, D, DIN, 3}, {args.in[22], WO, D, D, 0}};
          transpose_jobs<5>(C, jobs); }
        { const int gt = C.vcu * (NWAVES * 64) + (int)threadIdx.x; const int NGT = C.G * NWAVES * 64; v4u* z = (v4u*)(W3 + (size_t)DIN * D);
          for (int i = gt; i < (NPROJ - DIN) * D / 8; i += NGT) z[i] = (v4u){0u, 0u, 0u, 0u}; }
        rows_norm0(C, args, args.in[9], XN1);
    );
    PHASE(1, { pg8::Gemm g{XN1, WGU1, MP, 2 * FF, D}; pg8::StaticOrder S; S.init(MP, 2 * FF, C.G, (int)blockIdx.x); pg8::EpiSwiGLU E{HID, FF};
        pg8::gemm_phase<pg8::EpiSwiGLU, pg8::StaticOrder, true, true>(C.lds, g, S, E); });
    PHASE(2, { pg8::Gemm g{HID, WD1, MP, D, FF}; pg8::EpiSplit E{Fb, FB2, D};
        pg8::gemm_phase<pg8::EpiSplit, pg8::SplitK, true, true>(C.lds, g, SKd, E); });
    PHASE(3, rows_mid<true>(C, args, Fb, FB2, SKd, args.in[10], 0.5f, args.in[14], XN1););
    PHASE(4, { pg8::Gemm g{XN1, W3, MP, NPROJ, D}; pg8::StaticOrder S; S.init(MP, NPROJ, C.G, (int)blockIdx.x);
        pg8::EpiProj E{(bf16*)(ws + WS_QKV), (bf16*)(ws + WS_SQ), (bf16*)(ws + WS_SKV), (bf16*)(ws + WS_GD), (bf16*)(ws + WS_GS), (float*)(ws + WS_BA)};
        pg8::gemm_phase<pg8::EpiProj, pg8::StaticOrder, true, true>(C.lds, g, S, E);
        { const TrJob jobs[3] = {{args.in[25], WGU2, D, FF, 1}, {args.in[26], WGU2, D, FF, 2}, {args.in[27], WD2, FF, D, 0}};
          const int nb = (transpose_total<3>(jobs) + 5 * NWAVES - 1) / (5 * NWAVES);
          for (;;) { const int b = queue_next(C, 4 + 8 * rp); if (b >= nb) break; transpose_batch<3>(C, jobs, b); } } });
#pragma unroll 1
    for (int half = 0; half < 2; ++half) {
        const int jbase = half ? CH1 : 0, nc = half ? NCH - CH1 : CH1;
        PHASE(5 + 2 * half,
            const int nitems = 32 * nc;
            int it = queue_next(C, half + 8 * rp); PreLd L;
            if (it < nitems) { int n0, h0, j0, nh0, jl0; pre_item_of(it, jbase, n0, h0, j0, nh0, jl0); pre_issue(args, n0, h0, j0, L); }
            while (it < nitems) it = dn_pre_item(C, args, it, jbase, nitems, half + 8 * rp, sreg, L);
        );
        PHASE(6 + 2 * half, for (int it = C.vcu; it < 256; it += C.G) { dn_scan_item(C, args, it >> 3, it & 7, jbase, nc, half == 0); __syncthreads(); });
    }
    PHASE(9,
        constexpr int NPI = NB * KVH * NCH, NSD = SB * NH / 2;
        static_assert(NPI >= NSD && NSD == 512 && NB * 144 * 64 == 512 * 72, "queue interleave / copy slices");
        for (;;) { const int it = queue_next(C, 3 + 8 * rp); if (it >= NPI + NSD + SB * KVH) break;
            int pi = -1, sd = -1, si = -1;
            if (it < 2 * NSD) { if (it & 1) sd = it >> 1; else pi = it >> 1; }
            else if (it < NPI + NSD) pi = it - NSD;
            else si = it - NPI - NSD;
            if (sd >= 0) { sdn_batch(C, args, sd); state_copies(C, args, sd); }
            else if (pi >= 0) { const int jb = pi % NCH, r = pi / NCH; swa_item<false>(C, args, r >> 1, r & 1, jb); }
            else { const int n = si >> 1;
                if (C.wave == 0) { gu32* cw = C.ctl + CW_SDN + 16 * n; unsigned sp = 0;
                    while ((unsigned)__builtin_amdgcn_readfirstlane(__hip_atomic_load(cw, RLX_AGENT)) < 4u) { __builtin_amdgcn_s_sleep(2); if (++sp > (1u << 22)) break; }
                    __builtin_amdgcn_fence(__ATOMIC_ACQUIRE, "agent"); asm volatile("s_waitcnt vmcnt(0)" ::: "memory"); }
                __syncthreads();
                swa_item<true>(C, args, n, si & 1, 0); } }
    );
    PHASE(11,
        pg8::Gemm g{(const bf16*)(ws + WS_GD), WO, MP, D, D}; pg8::EpiSplit E{Fb, FB2, D};
        pg8::gemm_phase<pg8::EpiSplit, pg8::SplitK, true, true>(C.lds, g, SKo, E);
    );
    PHASE(12, rows_mid<false>(C, args, Fb, FB2, SKo, args.in[15], 1.0f, args.in[23], XN2););
    PHASE(13, { pg8::Gemm g{XN2, WGU2, MP, 2 * FF, D}; pg8::StaticOrder S; S.init(MP, 2 * FF, C.G, (int)blockIdx.x); pg8::EpiSwiGLU E{HID, FF};
        pg8::gemm_phase<pg8::EpiSwiGLU, pg8::StaticOrder, true, true>(C.lds, g, S, E); });
    PHASE(14, { pg8::Gemm g{HID, WD2, MP, D, FF}; pg8::EpiSplit E{Fb, FB2, D};
        pg8::gemm_phase<pg8::EpiSplit, pg8::SplitK, true, true>(C.lds, g, SKd, E); });
    PHASE(15, rows_final(C, args, Fb, FB2, SKd, args.in[24]););
#undef PHASE
#undef IN
#undef SEAM
}

extern "C" void kernel_launch(void* const* d_in, const int* in_sizes, int n_in, void* d_out, int out_size, void* d_ws, size_t ws_size, hipStream_t stream) {
    static int grid = 0;
    if (grid == 0) {
        if (n_in != 28 || out_size != (int)O_END || ws_size < WS_END) { fprintf(stderr, "kernel_launch: unexpected shapes (n_in %d, out %d, ws %zu); nothing launched\n", n_in, out_size, ws_size); grid = -1; return; }
        int dev = 0, cus = 0, per_cu = 0;
        if (hipGetDevice(&dev) != hipSuccess || hipDeviceGetAttribute(&cus, hipDeviceAttributeMultiprocessorCount, dev) != hipSuccess) { grid = -1; return; }
        if (hipFuncSetAttribute((const void*)hyb_fwd, hipFuncAttributeMaxDynamicSharedMemorySize, LDS_BYTES) != hipSuccess) { fprintf(stderr, "kernel_launch: hipFuncSetAttribute failed\n"); grid = -1; return; }
        if (hipOccupancyMaxActiveBlocksPerMultiprocessor(&per_cu, (const void*)hyb_fwd, NWAVES * 64, LDS_BYTES) != hipSuccess || per_cu < 1)
            fprintf(stderr, "kernel_launch: note: occupancy query reports %d workgroups per CU\n", per_cu);
        (void)hipGetLastError();
        grid = cus;
    }
    if (grid < 0) return;
    if (hipMemsetAsync((char*)d_ws + WS_CTL, 0, CTL_ZERO_BYTES, stream) != hipSuccess) { fprintf(stderr, "kernel_launch: memset failed\n"); return; }
    Args a{};
    for (int i = 0; i < 28; ++i) a.in[i] = (const float*)d_in[i];
    a.out = (float*)d_out; a.ws = (unsigned char*)d_ws;
    for (int li = 0; li < MK_N_LAUNCHES; ++li) {
        a.ph_lo = (MK_N_LAUNCHES == 1) ? 0 : li; a.ph_hi = (MK_N_LAUNCHES == 1) ? NPHASE : li + 1; a.li = li;
        hipLaunchKernelGGL(hyb_fwd, dim3(grid), dim3(NWAVES * 64), LDS_BYTES, stream, a);
        const hipError_t le = hipPeekAtLastError();
        if (le != hipSuccess) { fprintf(stderr, "kernel_launch: launch %d failed: %s\n", li, hipGetErrorName(le)); break; }
    }
}
```
